# Optimizing an MI355X kernel written in HIP

```python
import math
import jax, jax.numpy as jnp
from jax import lax
import numpy as np

D_MODEL = 1024
BATCH = 16
SEQ = 2048
DEPTH = 2

HEAD_DIM = 64
SB_HEADS = 8
DIFF_HEADS = 4
SWA_Q_HEADS = 8
SWA_KV_HEADS = 2
SWA_GROUP = SWA_Q_HEADS // SWA_KV_HEADS
WINDOW = 128
BLOCK = 128
D_FF = 2816
N_BUCKETS = 32
MAX_DISTANCE = 128
N_BIAS_HEADS = DIFF_HEADS + SWA_Q_HEADS
EPS = 1e-6

SB_W = SB_HEADS * HEAD_DIM
DIFF_QK_W = DIFF_HEADS * 2 * HEAD_DIM
DIFF_V_W = DIFF_HEADS * 2 * HEAD_DIM
SWA_Q_W = SWA_Q_HEADS * HEAD_DIM
SWA_KV_W = SWA_KV_HEADS * HEAD_DIM
IN_WIDTHS = (SB_W, SB_W, SB_W, DIFF_QK_W, DIFF_QK_W, DIFF_V_W,
             SWA_Q_W, SWA_KV_W, SWA_KV_W, D_MODEL, D_MODEL, D_MODEL)
IN_W = SB_W * 3 + DIFF_QK_W * 2 + DIFF_V_W + SWA_Q_W + 2 * SWA_KV_W + 3 * D_MODEL

kernel_name = "hybrid_sb_diff_swa_macaron"


def _offsets(widths):
    out, acc = [], 0
    for w in widths[:-1]:
        acc += w
        out.append(acc)
    return out


def rmsnorm(x, g):
    xf = x.astype(jnp.float32)
    y = xf * lax.rsqrt(jnp.mean(xf * xf, axis=-1, keepdims=True) + EPS)
    return (y * g.astype(jnp.float32)).astype(x.dtype)


def swiglu(h, w_in, w_out):
    g, u = jnp.split(h @ w_in, 2, axis=-1)
    return (jax.nn.silu(g) * u) @ w_out


def t5_bucket(dist):
    n = jnp.maximum(dist, 0)
    max_exact = N_BUCKETS // 2
    is_small = n < max_exact
    nf = jnp.maximum(n, 1).astype(jnp.float32)
    large = max_exact + (jnp.log(nf / max_exact) / math.log(MAX_DISTANCE / max_exact)
                         * (N_BUCKETS - max_exact)).astype(jnp.int32)
    large = jnp.minimum(large, N_BUCKETS - 1)
    return jnp.where(is_small, n, large)


def stick_breaking_attention(q, k, v):
    S = q.shape[1]
    scale = HEAD_DIM ** -0.5
    outs = []
    for i in range(S // BLOCK):
        q0 = i * BLOCK
        L = q0 + BLOCK
        z = jnp.einsum('bqhd,bkhd->bhqk', q[:, q0:L], k[:, :L],
                       preferred_element_type=jnp.float32) * scale
        t = q0 + jnp.arange(BLOCK)[:, None]
        s = jnp.arange(L)[None, :]
        mask = s < t
        log_fail = jnp.where(mask, jax.nn.log_sigmoid(-z), 0.0)
        between = lax.cumsum(log_fail, axis=3, reverse=True) - log_fail
        w = jnp.where(mask, jnp.exp(jax.nn.log_sigmoid(z) + between), 0.0)
        outs.append(jnp.einsum('bhqk,bkhd->bqhd', w.astype(v.dtype), v[:, :L]))
    return jnp.concatenate(outs, axis=1)


def differential_attention(q, k, v, bias_table, lam, lam_init, sub_gain):
    B, S = q.shape[0], q.shape[1]
    scale = HEAD_DIM ** -0.5
    outs = []
    for i in range(S // BLOCK):
        q0 = i * BLOCK
        L = q0 + BLOCK
        z = jnp.einsum('bqhcd,bkhcd->bhcqk', q[:, q0:L], k[:, :L],
                       preferred_element_type=jnp.float32) * scale
        dist = (q0 + jnp.arange(BLOCK))[:, None] - jnp.arange(L)[None, :]
        bias = bias_table[t5_bucket(dist)].astype(jnp.float32).transpose(2, 0, 1)
        z = jnp.where(dist >= 0, z + bias[None, :, None], -jnp.inf)
        p = jax.nn.softmax(z, axis=-1)
        w = p[:, :, 0] - lam * p[:, :, 1]
        outs.append(jnp.einsum('bhqk,bkhe->bqhe', w.astype(v.dtype), v[:, :L]))
    o = jnp.concatenate(outs, axis=1)
    o = rmsnorm(o, sub_gain) * (1.0 - lam_init)
    return o.reshape(B, S, DIFF_HEADS * 2 * HEAD_DIM)


def sliding_window_attention(q, k, v, bias_table, sinks):
    B, S = q.shape[0], q.shape[1]
    nb = S // BLOCK
    scale = HEAD_DIM ** -0.5
    qb = q.reshape(B, nb, BLOCK, SWA_KV_HEADS, SWA_GROUP, HEAD_DIM)
    kb = k.reshape(B, nb, BLOCK, SWA_KV_HEADS, HEAD_DIM)
    vb = v.reshape(B, nb, BLOCK, SWA_KV_HEADS, HEAD_DIM)
    pad = ((0, 0), (1, 0), (0, 0), (0, 0), (0, 0))
    kw = jnp.concatenate([jnp.pad(kb, pad)[:, :-1], kb], axis=2)
    vw = jnp.concatenate([jnp.pad(vb, pad)[:, :-1], vb], axis=2)
    z = jnp.einsum('bnqhgd,bnkhd->bnhgqk', qb, kw,
                   preferred_element_type=jnp.float32) * scale
    a = jnp.arange(BLOCK)[:, None]
    c = jnp.arange(2 * BLOCK)[None, :]
    dist = BLOCK + a - c
    band = (dist >= 0) & (dist < WINDOW)
    valid = band[None] & ((jnp.arange(nb)[:, None, None] > 0) | (c >= BLOCK)[None])
    bias = bias_table[t5_bucket(dist)].astype(jnp.float32)
    bias = bias.reshape(BLOCK, 2 * BLOCK, SWA_KV_HEADS, SWA_GROUP).transpose(2, 3, 0, 1)
    z = jnp.where(valid[None, :, None, None], z + bias[None, None], -jnp.inf)
    sink = sinks.astype(jnp.float32).reshape(SWA_KV_HEADS, SWA_GROUP)
    sink_col = jnp.broadcast_to(sink[None, None, :, :, None, None], z.shape[:-1] + (1,))
    p = jax.nn.softmax(jnp.concatenate([z, sink_col], axis=-1), axis=-1)[..., :-1]
    o = jnp.einsum('bnhgqk,bnkhd->bnqhgd', p.astype(v.dtype), vw)
    return o.reshape(B, S, SWA_Q_HEADS * HEAD_DIM)


def hybrid_mixer(h, w_in, q_norm_diff, k_norm_diff, q_norm_swa, k_norm_swa, lam_vecs, lam_init,
                 diff_subln, sinks, rel_bias, w_proj_sb, w_proj_diff, w_proj_swa, w_out):
    B, S, _ = h.shape
    proj = h @ w_in
    (qa, ka, va, qd, kd, vd, qs, ks, vs, ga, gd, gs) = jnp.split(proj, _offsets(IN_WIDTHS), axis=-1)
    hd = (B, S, SB_HEADS, HEAD_DIM)
    o_sb = stick_breaking_attention(qa.reshape(hd), ka.reshape(hd), va.reshape(hd)).reshape(B, S, SB_W)
    qd = rmsnorm(qd.reshape(B, S, DIFF_HEADS, 2, HEAD_DIM), q_norm_diff)
    kd = rmsnorm(kd.reshape(B, S, DIFF_HEADS, 2, HEAD_DIM), k_norm_diff)
    vd = vd.reshape(B, S, DIFF_HEADS, 2 * HEAD_DIM)
    lv = lam_vecs.astype(jnp.float32)
    lam = jnp.exp(jnp.sum(lv[0] * lv[1])) - jnp.exp(jnp.sum(lv[2] * lv[3])) + lam_init
    o_diff = differential_attention(qd, kd, vd, rel_bias[:, :DIFF_HEADS], lam, lam_init, diff_subln)
    qs = rmsnorm(qs.reshape(B, S, SWA_KV_HEADS, SWA_GROUP, HEAD_DIM), q_norm_swa)
    ks = rmsnorm(ks.reshape(B, S, SWA_KV_HEADS, HEAD_DIM), k_norm_swa)
    vs = vs.reshape(B, S, SWA_KV_HEADS, HEAD_DIM)
    o_swa = sliding_window_attention(qs, ks, vs, rel_bias[:, DIFF_HEADS:], sinks)
    merged = (jax.nn.sigmoid(ga) * (o_sb @ w_proj_sb)
              + jax.nn.sigmoid(gd) * (o_diff @ w_proj_diff)
              + jax.nn.sigmoid(gs) * (o_swa @ w_proj_swa))
    return merged @ w_out


def setup_inputs(seed: int = 0) -> dict:
    key = jax.random.key(seed)
    ks = jax.random.split(key, 24)
    f32 = jnp.float32

    def w(k, shape, fan_in):
        return jax.random.normal(k, shape, f32) * (fan_in ** -0.5)

    def gain(k, shape):
        return 1.0 + 0.01 * jax.random.normal(k, shape, f32)

    return {
        "x": jax.random.normal(ks[0], (BATCH, SEQ, D_MODEL), f32),
        "ffn1_norm": gain(ks[1], (DEPTH, D_MODEL)),
        "ffn1_w_in": w(ks[2], (DEPTH, D_MODEL, 2 * D_FF), D_MODEL),
        "ffn1_w_out": w(ks[3], (DEPTH, D_FF, D_MODEL), D_FF),
        "mix_norm": gain(ks[4], (DEPTH, D_MODEL)),
        "w_in": w(ks[5], (DEPTH, D_MODEL, IN_W), D_MODEL),
        "q_norm_diff": gain(ks[6], (DEPTH, HEAD_DIM)),
        "k_norm_diff": gain(ks[7], (DEPTH, HEAD_DIM)),
        "q_norm_swa": gain(ks[8], (DEPTH, HEAD_DIM)),
        "k_norm_swa": gain(ks[9], (DEPTH, HEAD_DIM)),
        "diff_lambda": 0.1 * jax.random.normal(ks[10], (DEPTH, 4, HEAD_DIM), f32),
        "diff_subln": gain(ks[11], (DEPTH, 2 * HEAD_DIM)),
        "swa_sinks": 0.5 * jax.random.normal(ks[12], (DEPTH, SWA_Q_HEADS), f32),
        "rel_bias": 0.5 * jax.random.normal(ks[13], (N_BUCKETS, N_BIAS_HEADS), f32),
        "w_proj_sb": w(ks[14], (DEPTH, SB_W, D_MODEL), SB_W),
        "w_proj_diff": w(ks[15], (DEPTH, DIFF_V_W, D_MODEL), DIFF_V_W),
        "w_proj_swa": w(ks[16], (DEPTH, SWA_Q_W, D_MODEL), SWA_Q_W),
        "w_out": w(ks[17], (DEPTH, D_MODEL, D_MODEL), D_MODEL),
        "ffn2_norm": gain(ks[18], (DEPTH, D_MODEL)),
        "ffn2_w_in": w(ks[19], (DEPTH, D_MODEL, 2 * D_FF), D_MODEL),
        "ffn2_w_out": w(ks[20], (DEPTH, D_FF, D_MODEL), D_FF),
    }


def reference(x, ffn1_norm, ffn1_w_in, ffn1_w_out, mix_norm, w_in, q_norm_diff, k_norm_diff,
              q_norm_swa, k_norm_swa, diff_lambda, diff_subln, swa_sinks, rel_bias,
              w_proj_sb, w_proj_diff, w_proj_swa, w_out, ffn2_norm, ffn2_w_in, ffn2_w_out):
    for l in range(DEPTH):
        lam_init = 0.8 - 0.6 * math.exp(-0.3 * l)
        x = x + 0.5 * swiglu(rmsnorm(x, ffn1_norm[l]), ffn1_w_in[l], ffn1_w_out[l])
        x = x + hybrid_mixer(rmsnorm(x, mix_norm[l]), w_in[l], q_norm_diff[l], k_norm_diff[l],
                             q_norm_swa[l], k_norm_swa[l], diff_lambda[l], lam_init, diff_subln[l],
                             swa_sinks[l], rel_bias, w_proj_sb[l], w_proj_diff[l], w_proj_swa[l],
                             w_out[l])
        x = x + 0.5 * swiglu(rmsnorm(x, ffn2_norm[l]), ffn2_w_in[l], ffn2_w_out[l])
    return x
```

```cpp
#include <hip/hip_runtime.h>
#include <hip/hip_cooperative_groups.h>
#include <cstdio>
#include <cstdint>
namespace cg = cooperative_groups;

#ifndef MK_PER_PHASE_LAUNCH
#define MK_PER_PHASE_LAUNCH 0
#endif

#define LAS __attribute__((address_space(3)))
#define DI __device__ __forceinline__
typedef unsigned short bf16_t;
typedef short bf16x8 __attribute__((ext_vector_type(8)));
typedef short s16x4 __attribute__((ext_vector_type(4)));
typedef float f32x4 __attribute__((ext_vector_type(4)));
typedef float f32x16 __attribute__((ext_vector_type(16)));
typedef unsigned u32x4 __attribute__((ext_vector_type(4)));

constexpr int M_ = 32768, D_ = 1024, FF_ = 2816, SEQ_ = 2048;
constexpr float EPS_ = 1e-6f, LOG2E_ = 1.4426950408889634f, LN2_ = 0.6931471805599453f;
constexpr size_t MiB = (size_t)1 << 20;
constexpr size_t WS_PART = 0, WS_W = 2 * MiB, W_LAYER = 52 * MiB;
constexpr size_t W_1A = 0, W_2A = 11 * MiB, W_IN = 16 * MiB + MiB / 2, W_P = 30 * MiB, W_O = 33 * MiB, W_1B = 35 * MiB, W_2B = 46 * MiB;
constexpr size_t WS_X1 = 106 * MiB, WS_R = 170 * MiB, WS_CTL = 458 * MiB, CTL_BYTES = 65536, WS_END = 459 * MiB;
constexpr size_t R_QA = 0, R_QD = 32 * MiB, R_QS = 64 * MiB, R_KA = 96 * MiB, R_VA = 128 * MiB, R_KD = 160 * MiB, R_VD = 192 * MiB, R_KS = 224 * MiB, R_VS = 232 * MiB;
constexpr size_t R_G = 96 * MiB, R_HID = 0, R_X2 = 176 * MiB;
constexpr int LDS_BYTES = 147456, LDS_LUT = 131072, LDS_PTAB = 139264, LDS_BARST = 139776, LDS_FLG = 140288, LDS_WSF2 = 140416, LDS_OSTG = 67584;

DI unsigned cvtpk(float lo, float hi) { typedef float f2 __attribute__((ext_vector_type(2))); typedef __bf16 b2 __attribute__((ext_vector_type(2))); f2 v = {lo, hi}; b2 b = __builtin_convertvector(v, b2); return __builtin_bit_cast(unsigned, b); }
DI u32x4 pack8(f32x4 a, f32x4 b) { u32x4 w; w.x = cvtpk(a[0], a[1]); w.y = cvtpk(a[2], a[3]); w.z = cvtpk(b[0], b[1]); w.w = cvtpk(b[2], b[3]); return w; }
DI float bf2f(unsigned short h) { return __builtin_bit_cast(float, (unsigned)h << 16); }
DI void unpack8(u32x4 w, f32x4& a, f32x4& b) {
    a[0] = __builtin_bit_cast(float, w.x << 16); a[1] = __builtin_bit_cast(float, w.x & 0xffff0000u); a[2] = __builtin_bit_cast(float, w.y << 16); a[3] = __builtin_bit_cast(float, w.y & 0xffff0000u);
    b[0] = __builtin_bit_cast(float, w.z << 16); b[1] = __builtin_bit_cast(float, w.z & 0xffff0000u); b[2] = __builtin_bit_cast(float, w.w << 16); b[3] = __builtin_bit_cast(float, w.w & 0xffff0000u); }
DI unsigned long long rfl64(unsigned long long v) { const unsigned lo = __builtin_amdgcn_readfirstlane((unsigned)v), hi = __builtin_amdgcn_readfirstlane((unsigned)(v >> 32)); return ((unsigned long long)hi << 32) | lo; }
DI float fexp2(float x) { return __builtin_amdgcn_exp2f(x); }
DI float flog2(float x) { return __builtin_amdgcn_logf(x); }
DI float frcp(float x) { return __builtin_amdgcn_rcpf(x); }
DI float frsq(float x) { return __builtin_amdgcn_rsqf(x); }
DI float sigmoidf_(float x) { return frcp(1.0f + fexp2(-x * LOG2E_)); }
DI float psum32(float v) { float a = v, b = v; asm volatile("s_nop 1\n\tv_permlane32_swap_b32 %0, %1" : "+v"(a), "+v"(b)); return a + b; }
DI float psum16(float v) { float a = v, b = v; asm volatile("s_nop 1\n\tv_permlane16_swap_b32 %0, %1" : "+v"(a), "+v"(b)); return a + b; }
DI float wave_sum(float v) {
#pragma unroll
    for (int o = 1; o < 64; o <<= 1) v += __shfl_xor(v, o);
    return v; }

namespace pg8 {
constexpr int BM = 256, BK = 64, HALF = 128, HTB = HALF * BK * 2, STAGE_BYTES = 8 * HTB, NXCD = 8, WGM = 8;
DI int lds_byte(int r, int c) { const int st = (r >> 4) * 2 + (c >> 5), rr = r & 15, cc = c & 31, ob = rr * 64 + cc * 2; return st * 1024 + (ob ^ (((ob >> 9) & 1) << 5)); }
DI void stage_rc(int b, int& R, int& C) { const int st = b / 1024, sb = b % 1024, swz = sb ^ (((sb >> 9) & 1) << 5); R = (st >> 1) * 16 + swz / 64; C = (st & 1) * 32 + (swz % 64) / 2; }
DI int perm32(int rho) { const int n = rho >> 4, i = rho & 15; return 8 * (i >> 2) + 4 * n + (i & 3); }

struct Unit { int pm, pn, br; };
struct Gemm { const bf16_t *A0, *B0; size_t sA, sB; int K, nM, nN, nbr, b_tile_rows, b_half_rows, b_spread; };
DI const char* selA(const Gemm& g, int br) { return (const char*)g.A0 + (size_t)br * g.sA; }
DI const char* selB(const Gemm& g, int br) { return (const char*)g.B0 + (size_t)br * g.sB; }

DI bool next_unit(const Gemm& g, int i, Unit& u) {
    const int G = gridDim.x, c = blockIdx.x; const int nM = g.nM, nN = g.nN, nwg = nM * nN;
    const int ti = i / g.nbr; u.br = i - ti * g.nbr;
    const long L = (long)ti * G + c; if (L >= nwg) return false;
    int wgid = (int)L; { const int q = nwg / NXCD, r = nwg % NXCD, xcd = wgid % NXCD, off = wgid / NXCD; wgid = (xcd < r ? xcd * (q + 1) : r * (q + 1) + (xcd - r) * q) + off; }
    const int nig = WGM * nN, gid = wgid / nig, fm = gid * WGM, gsz = (nM - fm) < WGM ? (nM - fm) : WGM;
    u.pm = fm + ((wgid % nig) % gsz); u.pn = (wgid % nig) / gsz; return true;
}

template <class Epi>
DI void gemm_phase(LAS unsigned char* lds, const Gemm& g, const Epi& E) {
    int tid_ = threadIdx.x; asm volatile("" : "+v"(tid_));
    const int tid = tid_, wid = __builtin_amdgcn_readfirstlane(tid >> 6), lane = tid & 63, wr = wid >> 2, wc = wid & 3, fr = lane & 15, fq = lane >> 4;
    const int K = g.K, nt = K / BK;
    unsigned voffA[2], voffB[2];
#pragma unroll
    for (int i = 0; i < 2; ++i) { int R, C; stage_rc(tid * 16 + i * 8192, R, C); int Rb = (R & ~31) + perm32(R & 31); if (g.b_spread) Rb = ((Rb >> 5) << 6) + (Rb & 31);
        voffA[i] = (unsigned)(R * K + C) * 2u; voffB[i] = (unsigned)(Rb * K + C) * 2u; }
    const size_t kstep = (size_t)(BK * 2);
    const size_t hA = (size_t)HALF * K * 2, hB = (size_t)g.b_half_rows * K * 2;
    const size_t tA = (size_t)BM * K * 2, tB = (size_t)g.b_tile_rows * K * 2;
    const unsigned ldsw = (unsigned)wid * 1024u;
    const int aoff = lds_byte(wr * 64 + fr, fq * 8), boff = lds_byte(wc * 32 + fr, fq * 8);
#define PG8_SA(b, h) (((b) * 2 + (h)) * HTB)
#define PG8_SB(b, h) ((4 + (b) * 2 + (h)) * HTB)
#define PG8_STAGE(bufoff, gbase, voff) do { _Pragma("unroll") for (int _i = 0; _i < 2; ++_i) \
        __builtin_amdgcn_global_load_lds((const unsigned*)((const char*)(gbase) + (voff)[_i]), (LAS unsigned*)(lds + (bufoff) + ldsw + _i * 8192), 16, 0, 0); } while (0)
#define PG8_LDA(dst, b, h) do { _Pragma("unroll") for (int m = 0; m < 4; ++m) _Pragma("unroll") for (int k = 0; k < 2; ++k) dst[m][k] = *(const LAS bf16x8*)(lds + PG8_SA(b, h) + aoff + m * 2048 + k * 1024); } while (0)
#define PG8_LDB(dst, b, h) do { _Pragma("unroll") for (int n = 0; n < 2; ++n) _Pragma("unroll") for (int k = 0; k < 2; ++k) dst[n][k] = *(const LAS bf16x8*)(lds + PG8_SB(b, h) + boff + n * 2048 + k * 1024); } while (0)
#define PG8_MMA(ai, bj, At, Bt) do { __builtin_amdgcn_s_setprio(1); _Pragma("unroll") for (int m = 0; m < 4; ++m) _Pragma("unroll") for (int n = 0; n < 2; ++n) _Pragma("unroll") for (int k = 0; k < 2; ++k) \
        acc[ai][bj][m][n] = __builtin_amdgcn_mfma_f32_16x16x32_bf16(Bt[n][k], At[m][k], acc[ai][bj][m][n], 0, 0, 0); __builtin_amdgcn_s_setprio(0); } while (0)
#define PG8_WAIT_V(n) asm volatile("s_waitcnt vmcnt(" #n ")" ::: "memory")
#define PG8_WAIT_L(n) asm volatile("s_waitcnt lgkmcnt(" #n ")" ::: "memory")
#define PG8_BAR __builtin_amdgcn_s_barrier()
#define PG8_SCHED __builtin_amdgcn_sched_barrier(0)
    Unit cur, nxt; int ui = 0;
    if (!next_unit(g, 0, cur)) return;
    f32x4 acc[2][2][4][2];
#pragma unroll
    for (int a = 0; a < 2; ++a)
#pragma unroll
        for (int b = 0; b < 2; ++b)
#pragma unroll
            for (int m = 0; m < 4; ++m)
#pragma unroll
                for (int n = 0; n < 2; ++n) acc[a][b][m][n] = (f32x4){0.f, 0.f, 0.f, 0.f};
    bf16x8 At[4][2], B0[2][2], B1[2][2];
    const char* cA = selA(g, cur.br) + (size_t)cur.pm * tA; const char* cB = selB(g, cur.br) + (size_t)cur.pn * tB;
    PG8_STAGE(PG8_SB(0, 0), cB, voffB); PG8_STAGE(PG8_SB(0, 1), cB + hB, voffB); PG8_STAGE(PG8_SA(0, 0), cA, voffA); PG8_STAGE(PG8_SA(0, 1), cA + hA, voffA);
    if (wr == 1) PG8_BAR;
    PG8_WAIT_V(2); PG8_BAR;
    PG8_STAGE(PG8_SB(1, 0), cB + kstep, voffB); PG8_STAGE(PG8_SA(1, 0), cA + kstep, voffA); PG8_STAGE(PG8_SB(1, 1), cB + hB + kstep, voffB);
    PG8_WAIT_V(6); PG8_BAR;
    for (;;) {
        const bool has_next = next_unit(g, ui + 1, nxt);
        const char* nA = has_next ? selA(g, nxt.br) + (size_t)nxt.pm * tA : cA; const char* nB = has_next ? selB(g, nxt.br) + (size_t)nxt.pn * tB : cB;
        for (int t = 0; t < nt; t += 2) {
            const bool last = (t == nt - 2);
            const char* a1 = cA + (size_t)(t + 1) * kstep;
            const char* a2 = last ? nA : cA + (size_t)(t + 2) * kstep; const char* b2 = last ? nB : cB + (size_t)(t + 2) * kstep;
            const char* a3 = a2 + kstep; const char* b3 = b2 + kstep;
            PG8_LDB(B0, 0, 0); PG8_LDB(B1, 0, 1); PG8_SCHED; PG8_LDA(At, 0, 0); PG8_STAGE(PG8_SA(1, 1), a1 + hA, voffA);
            PG8_WAIT_V(8); PG8_WAIT_L(0); PG8_BAR; PG8_MMA(0, 0, At, B0); PG8_MMA(0, 1, At, B1); PG8_BAR; PG8_SCHED;
            PG8_LDA(At, 0, 1); PG8_STAGE(PG8_SB(0, 0), b2, voffB); PG8_STAGE(PG8_SB(0, 1), b2 + hB, voffB); PG8_STAGE(PG8_SA(0, 0), a2, voffA);
            PG8_WAIT_V(8); PG8_WAIT_L(0); PG8_BAR; PG8_MMA(1, 0, At, B0); PG8_MMA(1, 1, At, B1); PG8_BAR; PG8_SCHED;
            PG8_LDB(B0, 1, 0); PG8_LDB(B1, 1, 1); PG8_SCHED; PG8_LDA(At, 1, 0); PG8_STAGE(PG8_SA(0, 1), a2 + hA, voffA);
            PG8_WAIT_V(8); PG8_WAIT_L(0); PG8_BAR; PG8_MMA(0, 0, At, B0); PG8_MMA(0, 1, At, B1); PG8_BAR; PG8_SCHED;
            PG8_LDA(At, 1, 1); PG8_STAGE(PG8_SB(1, 0), b3, voffB); PG8_STAGE(PG8_SB(1, 1), b3 + hB, voffB); PG8_STAGE(PG8_SA(1, 0), a3, voffA);
            PG8_WAIT_V(8); PG8_WAIT_L(0); PG8_BAR; PG8_MMA(1, 0, At, B0); PG8_MMA(1, 1, At, B1); PG8_BAR; PG8_SCHED;
        }
        if (wr == 0) PG8_BAR;
        E(acc, cur, wr, wc, fr, fq);
        if (!has_next) break;
        if (!(Epi::CHAIN_BR && nxt.br != 0))
#pragma unroll
        for (int a = 0; a < 2; ++a)
#pragma unroll
            for (int b = 0; b < 2; ++b)
#pragma unroll
                for (int m = 0; m < 4; ++m)
#pragma unroll
                    for (int n = 0; n < 2; ++n) acc[a][b][m][n] = (f32x4){0.f, 0.f, 0.f, 0.f};
        cur = nxt; cA = nA; cB = nB; ++ui;
        if (wr == 1) PG8_BAR;
    }
    PG8_WAIT_V(0);
    PG8_BAR;
#undef PG8_SA
#undef PG8_SB
#undef PG8_STAGE
#undef PG8_LDA
#undef PG8_LDB
#undef PG8_MMA
#undef PG8_WAIT_V
#undef PG8_WAIT_L
#undef PG8_BAR
#undef PG8_SCHED
}

typedef f32x4 Acc[2][2][4][2];
DI void load_rstd(const float* part, int row0, int fq, float (&rs)[2][4]) {
#pragma unroll
    for (int ai = 0; ai < 2; ++ai)
#pragma unroll
        for (int m = 0; m < 4; ++m) { const f32x4 a = *(const f32x4*)(part + (size_t)(row0 + ai * HALF + m * 16) * 16 + fq * 4);
            float s = (a[0] + a[1]) + (a[2] + a[3]); s = psum32(psum16(s));
            rs[ai][m] = frsq(s * (1.0f / 1024.0f) + EPS_); }
}

struct EpiSwiglu {
    static constexpr bool CHAIN_BR = false;
    bf16_t* H; const float* part;
    DI void operator()(const Acc& acc, const Unit& u, int wr, int wc, int fr, int fq) const {
        const int row0 = u.pm * BM + wr * 64 + fr, col0 = u.pn * 128 + wc * 32 + 8 * fq;
        float rs[2][4]; load_rstd(part, row0, fq, rs);
#pragma unroll
        for (int ai = 0; ai < 2; ++ai)
#pragma unroll
            for (int m = 0; m < 4; ++m) { const float r = rs[ai][m]; f32x4 h[2];
                const float rl = r * -LOG2E_, r2 = r * r;
#pragma unroll
                for (int n = 0; n < 2; ++n) { const f32x4 ga = acc[ai][0][m][n], ua = acc[ai][1][m][n];
#pragma unroll
                    for (int i = 0; i < 4; ++i) h[n][i] = (ga[i] * ua[i]) * (r2 * frcp(1.0f + fexp2(ga[i] * rl))); }
                *(u32x4*)(H + (size_t)(row0 + ai * HALF + m * 16) * FF_ + col0) = pack8(h[0], h[1]); }
    }
};
struct EpiRes {
    static constexpr bool CHAIN_BR = false;
    bf16_t* xb; float* outf; float* part; float alpha;
    DI void operator()(const Acc& acc, const Unit& u, int wr, int wc, int fr, int fq) const {
        const int row0 = u.pm * BM + wr * 64 + fr, col0 = u.pn * BM + wc * 64 + 8 * fq;
#pragma unroll
        for (int ai = 0; ai < 2; ++ai)
#pragma unroll
            for (int m = 0; m < 4; ++m) { const int r = row0 + ai * HALF + m * 16; float ss = 0.f;
#pragma unroll
                for (int bj = 0; bj < 2; ++bj) { const size_t off = (size_t)r * D_ + col0 + bj * 32;
                    f32x4 b0, b1; unpack8(*(const u32x4*)(xb + off), b0, b1);
                    const f32x4 v0 = b0 + acc[ai][bj][m][0] * alpha, v1 = b1 + acc[ai][bj][m][1] * alpha;
                    if (outf) { *(f32x4*)(outf + off) = v0; *(f32x4*)(outf + off + 4) = v1; }
                    else { *(u32x4*)(xb + off) = pack8(v0, v1);
                        ss += (v0[0] * v0[0] + v0[1] * v0[1]) + (v0[2] * v0[2] + v0[3] * v0[3]) + (v1[0] * v1[0] + v1[1] * v1[1]) + (v1[2] * v1[2] + v1[3] * v1[3]); } }
                if (!outf) { ss = psum32(psum16(ss)); if (fq == 0) part[(size_t)r * 16 + u.pn * 4 + wc] = ss; } }
    }
};
struct EpiQKV {
    static constexpr bool CHAIN_BR = false;
    const float* part; unsigned char* R; const float *gqd, *gkd, *gqs, *gks;
    DI void operator()(const Acc& acc, const Unit& u, int wr, int wc, int fr, int fq) const {
        const int L = u.pn * 256 + wc * 64; const int b = u.pm >> 3, t0 = (u.pm & 7) * 4 + wr;
        const int row0 = u.pm * BM + wr * 64 + fr;
        int kind; const float* gain = nullptr; size_t dsto; unsigned tstride = 8192;
        if (L < 512) { kind = 0; dsto = R_QA + (size_t)L * 2; }
        else if (L < 1024) { kind = 1; const int h = (L - 512) >> 6; dsto = R_KA + (size_t)((b * 8 + h) * 32) * 8192; }
        else if (L < 1536) { kind = 2; const int h = (L - 1024) >> 6; dsto = R_VA + (size_t)((b * 8 + h) * 32) * 8192; }
        else if (L < 2048) { kind = 0; gain = gqd; dsto = R_QD + (size_t)(L - 1536) * 2; }
        else if (L < 2560) { kind = 1; gain = gkd; const int idx = (L - 2048) >> 6; dsto = R_KD + (size_t)((b * 4 + (idx >> 1)) * 32) * 16384 + (idx & 1) * 8192; tstride = 16384; }
        else if (L < 3072) { kind = 2; const int idx = (L - 2560) >> 6; dsto = R_VD + (size_t)((b * 4 + (idx >> 1)) * 32) * 16384 + (idx & 1) * 8192; tstride = 16384; }
        else if (L < 3584) { kind = 0; gain = gqs; dsto = R_QS + (size_t)(L - 3072) * 2; }
        else if (L < 3712) { kind = 1; gain = gks; const int kvh = (L - 3584) >> 6; dsto = R_KS + (size_t)((b * 2 + kvh) * 32) * 8192; }
        else { kind = 2; const int kvh = (L - 3712) >> 6; dsto = R_VS + (size_t)((b * 2 + kvh) * 32) * 8192; }
        unsigned lane_off, sa, sm, sb;
        if (kind == 0) { lane_off = (unsigned)(row0 * 512 + 8 * fq) * 2u; sa = 128u * 512u * 2u; sm = 16u * 512u * 2u; sb = 64u; }
        else if (kind == 1) { lane_off = (unsigned)t0 * tstride + fq * 1024 + fr * 16; sa = 2u * tstride; sm = 256u; sb = 4096u; }
        else { lane_off = (unsigned)t0 * tstride + fr * 64 + fq * 16; sa = 2u * tstride; sm = 1024u; sb = 4096u; }
        unsigned char* pl = R + dsto + lane_off;
        const float qs = (kind == 0) ? 0.125f : 1.0f;
#pragma unroll
        for (int ai = 0; ai < 2; ++ai)
#pragma unroll
            for (int m = 0; m < 4; ++m) {
                const f32x4 s4 = *(const f32x4*)(part + (size_t)(row0 + ai * HALF + m * 16) * 16 + fq * 4);
                float sr = (s4[0] + s4[1]) + (s4[2] + s4[3]); sr = psum32(psum16(sr));
                const float r = frsq(sr * (1.0f / 1024.0f) + EPS_);
                f32x4 v[2][2]; float ss = 0.f;
#pragma unroll
                for (int bj = 0; bj < 2; ++bj)
#pragma unroll
                    for (int n = 0; n < 2; ++n) { v[bj][n] = acc[ai][bj][m][n] * r; const f32x4 x = v[bj][n]; ss += (x[0] * x[0] + x[1] * x[1]) + (x[2] * x[2] + x[3] * x[3]); }
                float sc = qs;
                if (gain) { ss = psum32(psum16(ss)); sc *= frsq(ss * (1.0f / 64.0f) + EPS_);
#pragma unroll
                    for (int bj = 0; bj < 2; ++bj)
#pragma unroll
                        for (int n = 0; n < 2; ++n) v[bj][n] *= *(const f32x4*)(gain + 32 * bj + 8 * fq + 4 * n); }
#pragma unroll
                for (int bj = 0; bj < 2; ++bj) *(u32x4*)(pl + ai * sa + m * sm + bj * sb) = pack8(v[bj][0] * sc, v[bj][1] * sc);
                if (m == 3) asm volatile("" ::: "memory");
            }
    }
};
struct EpiGate {
    static constexpr bool CHAIN_BR = false;
    const float* part; bf16_t* G;
    DI void operator()(const Acc& acc, const Unit& u, int wr, int wc, int fr, int fq) const {
        const int row0 = u.pm * BM + wr * 64 + fr, col0 = (u.pn & 3) * BM + wc * 64 + 8 * fq; bf16_t* Gb = G + (size_t)(u.pn >> 2) * M_ * D_;
        float rs[2][4]; load_rstd(part, row0, fq, rs);
#pragma unroll
        for (int ai = 0; ai < 2; ++ai)
#pragma unroll
            for (int m = 0; m < 4; ++m) { const float r = rs[ai][m];
#pragma unroll
                for (int bj = 0; bj < 2; ++bj) { f32x4 h[2];
#pragma unroll
                    for (int n = 0; n < 2; ++n)
#pragma unroll
                        for (int i = 0; i < 4; ++i) h[n][i] = fminf(fexp2(acc[ai][bj][m][n][i] * (r * -LOG2E_)), 1048576.0f);
                    *(u32x4*)(Gb + (size_t)(row0 + ai * HALF + m * 16) * D_ + col0 + bj * 32) = pack8(h[0], h[1]); } }
    }
};
struct EpiMerge {
    static constexpr bool CHAIN_BR = true;
    const bf16_t* G; bf16_t* Mg;
    DI void operator()(Acc& acc, const Unit& u, int wr, int wc, int fr, int fq) const {
        const int row0 = u.pm * BM + wr * 64 + fr, col0 = u.pn * BM + wc * 64 + 8 * fq;
        const bf16_t* Ga = G + (size_t)u.br * M_ * D_; const bf16_t* Gn = Ga + (size_t)M_ * D_;
#pragma unroll
        for (int ai = 0; ai < 2; ++ai)
#pragma unroll
            for (int m = 0; m < 4; ++m)
#pragma unroll
                for (int bj = 0; bj < 2; ++bj) { const size_t off = (size_t)(row0 + ai * HALF + m * 16) * D_ + col0 + bj * 32;
                    f32x4 a0, a1; unpack8(*(const u32x4*)(Ga + off), a0, a1);
#pragma unroll
                    for (int i = 0; i < 4; ++i) { a0[i] = frcp(1.0f + a0[i]); a1[i] = frcp(1.0f + a1[i]); }
                    if (u.br < 2) { f32x4 n0, n1; unpack8(*(const u32x4*)(Gn + off), n0, n1);
                        acc[ai][bj][m][0] *= a0 * (n0 + 1.0f); acc[ai][bj][m][1] *= a1 * (n1 + 1.0f); }
                    else *(u32x4*)(Mg + off) = pack8(acc[ai][bj][m][0] * a0, acc[ai][bj][m][1] * a1); }
    }
};
}

DI int crow(int r, int hi) { return (r & 3) + 8 * (r >> 2) + 4 * hi; }
typedef short v4i16_t __attribute__((ext_vector_type(4)));
DI s16x4 vtr(const LAS char* p) { return __builtin_bit_cast(s16x4, __builtin_amdgcn_ds_read_tr16_b64_v4i16((LAS v4i16_t*)p)); }
#define MFMA32(a, b, c) __builtin_amdgcn_mfma_f32_32x32x16_bf16((a), (b), (c), 0, 0, 0)

DI void qk_tile(f32x16& p0, f32x16& p1, const LAS char* kb, const bf16x8 (&qr)[4], int r32, int hi) {
    const LAS char* kp = kb + hi * 1024 + r32 * 16;
#pragma unroll
    for (int i = 0; i < 16; ++i) { p0[i] = 0.f; p1[i] = 0.f; }
    bf16x8 kf[8];
#pragma unroll
    for (int d0 = 0; d0 < 4; ++d0) { kf[2 * d0] = *(const LAS bf16x8*)(kp + d0 * 2048); kf[2 * d0 + 1] = *(const LAS bf16x8*)(kp + d0 * 2048 + 512); }
    __builtin_amdgcn_s_setprio(1);
#pragma unroll
    for (int d0 = 0; d0 < 4; ++d0) { p0 = MFMA32(kf[2 * d0], qr[d0], p0); p1 = MFMA32(kf[2 * d0 + 1], qr[d0], p1); }
    __builtin_amdgcn_s_setprio(0);
}
DI void pack_p(const f32x16& p0, const f32x16& p1, bf16x8 (&pa)[4]) {
    u32x4 w;
    w.x = cvtpk(p0[0], p0[1]); w.y = cvtpk(p0[2], p0[3]); w.z = cvtpk(p0[4], p0[5]); w.w = cvtpk(p0[6], p0[7]); pa[0] = __builtin_bit_cast(bf16x8, w);
    w.x = cvtpk(p0[8], p0[9]); w.y = cvtpk(p0[10], p0[11]); w.z = cvtpk(p0[12], p0[13]); w.w = cvtpk(p0[14], p0[15]); pa[1] = __builtin_bit_cast(bf16x8, w);
    w.x = cvtpk(p1[0], p1[1]); w.y = cvtpk(p1[2], p1[3]); w.z = cvtpk(p1[4], p1[5]); w.w = cvtpk(p1[6], p1[7]); pa[2] = __builtin_bit_cast(bf16x8, w);
    w.x = cvtpk(p1[8], p1[9]); w.y = cvtpk(p1[10], p1[11]); w.z = cvtpk(p1[12], p1[13]); w.w = cvtpk(p1[14], p1[15]); pa[3] = __builtin_bit_cast(bf16x8, w);
}
template <int NQ> DI void pv_tile(f32x16 (&o)[NQ], const LAS char* vb, int lane, int hi, const bf16x8 (&pa)[4]) {
    const LAS char* vp = vb + ((lane >> 4) & 1) * 32 + (lane & 3) * 8 + (4 * hi + ((lane & 15) >> 2)) * 64;
    __builtin_amdgcn_s_setprio(1);
#pragma unroll
    for (int qd = 0; qd < NQ; ++qd)
#pragma unroll
        for (int s = 0; s < 4; ++s) { const s16x4 lo = vtr(vp + qd * 4096 + s * 1024), hh = vtr(vp + qd * 4096 + s * 1024 + 512);
            const bf16x8 f = (bf16x8){lo[0], lo[1], lo[2], lo[3], hh[0], hh[1], hh[2], hh[3]};
            o[qd] = MFMA32(pa[s], f, o[qd]); if (s == 3) __builtin_amdgcn_sched_barrier(0); }
    __builtin_amdgcn_s_setprio(0);
}
DI void dma16(const unsigned char* gsrc, LAS char* ldst_wave) { __builtin_amdgcn_global_load_lds((const unsigned*)gsrc, (LAS unsigned*)ldst_wave, 16, 0, 0); }
DI float pair_sum(float v) { float a = v, b = v; asm volatile("s_nop 1\n\tv_permlane32_swap_b32 %0, %1" : "+v"(a), "+v"(b)); return a + b; }

DI void sb_prime(LAS char* lds, int tid, int b, int h, int qb, const bf16_t* QO, const unsigned char* KA, const unsigned char* VA, bf16x8 (&qr)[4]) {
    const int lane = tid & 63, r32 = lane & 31, hi = lane >> 5, wid = __builtin_amdgcn_readfirstlane(tid >> 6);
    const int q0 = qb * 256, qw = q0 + wid * 32;
    const bf16_t* Qw = QO + ((size_t)b * SEQ_ + qw) * 512 + h * 64;
#pragma unroll
    for (int d0 = 0; d0 < 4; ++d0) qr[d0] = *(const bf16x8*)(Qw + (size_t)r32 * 512 + d0 * 16 + hi * 8);
    const unsigned char* kimg = KA + (size_t)((b * 8 + h) * 32) * 8192 + tid * 16; const unsigned char* vimg = VA + (size_t)((b * 8 + h) * 32) * 8192 + tid * 16;
    const int T0 = q0 >> 6; LAS char* ldw = lds + wid * 1024;
#pragma unroll
    for (int k = 0; k < 4; ++k) { const int tj = T0 + k; LAS char* d = ldw + (tj % 6) * 16384; dma16(kimg + (size_t)tj * 8192, d); dma16(vimg + (size_t)tj * 8192, d + 8192); }
}
DI void sb_unit(LAS char* lds, int b, int h, int qb, int qb_next, bf16x8 (&qr)[4], bf16_t* QO, const unsigned char* KA, const unsigned char* VA) {
    int tid_ = threadIdx.x; asm volatile("" : "+v"(tid_));
    const int tid = tid_, lane = tid & 63, r32 = lane & 31, hi = lane >> 5, wid = __builtin_amdgcn_readfirstlane(tid >> 6);
    const int q0 = qb * 256, qw = q0 + wid * 32; const size_t rowbase = (size_t)b * SEQ_;
    bf16_t* Qw = QO + (rowbase + qw) * 512 + h * 64;
    const unsigned char* kimg = KA + (size_t)((b * 8 + h) * 32) * 8192 + tid * 16; const unsigned char* vimg = VA + (size_t)((b * 8 + h) * 32) * 8192 + tid * 16;
    const int t_q = qw + r32;
    float carry = 0.f; f32x16 o[2];
#pragma unroll
    for (int i = 0; i < 16; ++i) { o[0][i] = 0.f; o[1][i] = 0.f; }
    const int T0 = q0 >> 6;
    const int dj = (qw + 30) >> 6;
    LAS char* ldw = lds + wid * 1024;
    LAS unsigned* flg = (LAS unsigned*)(lds + LDS_FLG);
    __syncthreads();
    for (int it = 0; it <= T0 + 3; ++it) {
        bool wdone = true;
        { const int tn = T0 - it - 1; if (tn >= 0) { LAS char* d = ldw + (tn % 6) * 16384; dma16(kimg + (size_t)tn * 8192, d); dma16(vimg + (size_t)tn * 8192, d + 8192); } }
        const int j = dj - it;
        if (j >= 0) {
            const LAS char* kb = lds + (j % 6) * 16384; const LAS char* vb = kb + 8192; const int k_lo = j * 64;
            f32x16 p0, p1; qk_tile(p0, p1, kb, qr, r32, hi);
            const bool need_mask = (k_lo + 63 >= qw);
            int dbase = t_q - k_lo - 4 * hi; asm volatile("" : "+v"(dbase));
            f32x16 l0, l1;
#pragma unroll
            for (int r = 0; r < 16; ++r) {
                { const float z = p0[r]; const float e = fexp2(-fabsf(z) * LOG2E_); float lf = -(fmaxf(z, 0.f) + LN2_ * flog2(1.0f + e)); if (need_mask && (dbase - ((r & 3) + 8 * (r >> 2)) <= 0)) lf = 0.f; l0[r] = lf; }
                { const float z = p1[r]; const float e = fexp2(-fabsf(z) * LOG2E_); float lf = -(fmaxf(z, 0.f) + LN2_ * flog2(1.0f + e)); if (need_mask && (dbase - (32 + (r & 3) + 8 * (r >> 2)) <= 0)) lf = 0.f; l1[r] = lf; }
            }
            float own[8], P[8];
#pragma unroll
            for (int g = 0; g < 4; ++g) { own[g] = (l0[4 * g] + l0[4 * g + 1]) + (l0[4 * g + 2] + l0[4 * g + 3]); own[4 + g] = (l1[4 * g] + l1[4 * g + 1]) + (l1[4 * g + 2] + l1[4 * g + 3]); }
#pragma unroll
            for (int g = 0; g < 8; ++g) P[g] = pair_sum(own[g]);
            float suf = carry;
#pragma unroll
            for (int g = 7; g >= 0; --g) {
                float bt = suf + (hi == 0 ? (P[g] - own[g]) : 0.f);
#pragma unroll
                for (int i = 3; i >= 0; --i) { const int idx = 4 * (g & 3) + i;
                    if (g < 4) { const float lf = l0[idx]; float w = fexp2((p0[idx] + lf + bt) * LOG2E_); if (need_mask && (dbase - ((idx & 3) + 8 * (idx >> 2)) <= 0)) w = 0.f; p0[idx] = w; bt += lf; }
                    else { const float lf = l1[idx]; float w = fexp2((p1[idx] + lf + bt) * LOG2E_); if (need_mask && (dbase - (32 + (idx & 3) + 8 * (idx >> 2)) <= 0)) w = 0.f; p1[idx] = w; bt += lf; } }
                suf += P[g];
            }
            carry = suf;
            bf16x8 pa[4]; pack_p(p0, p1, pa);
            pv_tile<2>(o, vb, lane, hi, pa);
            wdone = (j == 0) || (__all(carry < -30.0f) != 0);
        }
        if (lane == 0) flg[(it & 1) * 8 + wid] = wdone ? 1u : 0u;
        __syncthreads();
        { const LAS u32x4* f4 = (const LAS u32x4*)(flg + (it & 1) * 8); const u32x4 fa = f4[0], fb = f4[1];
          if ((fa.x & fa.y & fa.z & fa.w & fb.x & fb.y & fb.z & fb.w) != 0u) break; }
    }
    if (qb_next >= 0) sb_prime(lds, tid, b, h, qb_next, QO, KA, VA, qr);
    {
        LAS bf16_t* stg = (LAS bf16_t*)(lds + 98304) + wid * 2048;
#pragma unroll
        for (int r = 0; r < 16; ++r) { const int row = crow(r, hi);
#pragma unroll
            for (int d0 = 0; d0 < 2; ++d0) stg[row * 64 + d0 * 32 + r32] = (bf16_t)(cvtpk(o[d0][r], 0.f) & 0xffffu); }
        asm volatile("s_waitcnt lgkmcnt(0)" ::: "memory");
#pragma unroll
        for (int i = 0; i < 4; ++i) { const int row = i * 8 + (lane >> 3), ch = lane & 7; *(u32x4*)(Qw + (size_t)row * 512 + ch * 8) = *(const LAS u32x4*)(stg + row * 64 + ch * 8); }
        asm volatile("s_waitcnt lgkmcnt(0)" ::: "memory");
    }
}


template <bool WINDOW> DI float softmax_tile(f32x16& p0, f32x16& p1, const LAS float* lut, bool near, int dbase  ) {
    float s = 0.f;
    if (!near) { const float c = lut[128];
#pragma unroll
        for (int r = 0; r < 16; ++r) { p0[r] = fexp2(p0[r] * LOG2E_ + c); p1[r] = fexp2(p1[r] * LOG2E_ + c); s += p0[r] + p1[r]; }
    } else {
#pragma unroll
        for (int r = 0; r < 16; ++r) {
            { const int dist = dbase - ((r & 3) + 8 * (r >> 2)); const int idx = dist < 0 ? 0 : (dist > 128 ? 128 : dist); float w = fexp2(p0[r] * LOG2E_ + lut[idx]); if (dist < 0 || (WINDOW && dist >= 128)) w = 0.f; p0[r] = w; s += w; }
            { const int dist = dbase - (32 + (r & 3) + 8 * (r >> 2)); const int idx = dist < 0 ? 0 : (dist > 128 ? 128 : dist); float w = fexp2(p1[r] * LOG2E_ + lut[idx]); if (dist < 0 || (WINDOW && dist >= 128)) w = 0.f; p1[r] = w; s += w; }
            if ((r & 3) == 3) __builtin_amdgcn_sched_barrier(0);
        }
    }
    return s;
}

DI void diff_prime(LAS char* lds, int tid, int b, int h, int qb, const bf16_t* QO, const unsigned char* KD, const unsigned char* VD, bf16x8 (&qr)[4]) {
    const int lane = tid & 63, r32 = lane & 31, hi = lane >> 5, wid = __builtin_amdgcn_readfirstlane(tid >> 6);
    const int c = wid >> 2, wq = wid & 3, qw = qb * 128 + wq * 32;
    const bf16_t* Qw = QO + ((size_t)b * SEQ_ + qw) * 512 + h * 128;
#pragma unroll
    for (int d0 = 0; d0 < 4; ++d0) qr[d0] = *(const bf16x8*)(Qw + (size_t)r32 * 512 + c * 64 + d0 * 16 + hi * 8);
    const unsigned char* kimg = KD + (size_t)((b * 4 + h) * 32) * 16384 + tid * 16; const unsigned char* vimg = VD + (size_t)((b * 4 + h) * 32) * 16384 + tid * 16;
    LAS char* ldw = lds + wid * 1024;
    dma16(kimg, ldw); dma16(kimg + 8192, ldw + 8192); dma16(vimg, ldw + 16384); dma16(vimg + 8192, ldw + 24576);
}
DI void diff_unit(LAS char* lds, const LAS float* lut, int b, int h, int qb, int qb_next, bf16x8 (&qr)[4], bf16_t* QO, const unsigned char* KD, const unsigned char* VD, float lam, const float* subg, float oscale) {
    int tid_ = threadIdx.x; asm volatile("" : "+v"(tid_));
    const int tid = tid_, lane = tid & 63, r32 = lane & 31, hi = lane >> 5, wid = __builtin_amdgcn_readfirstlane(tid >> 6);
    const int c = wid >> 2, wq = wid & 3, q0 = qb * 128, qw = q0 + wq * 32; const size_t rowbase = (size_t)b * SEQ_;
    bf16_t* Qw = QO + (rowbase + qw) * 512 + h * 128;
    const unsigned char* kimg = KD + (size_t)((b * 4 + h) * 32) * 16384 + tid * 16; const unsigned char* vimg = VD + (size_t)((b * 4 + h) * 32) * 16384 + tid * 16;
    const int NT = (q0 + 128) / 64; const int t_q = qw + r32;
    float lsum = 0.f; f32x16 o[4];
#pragma unroll
    for (int i = 0; i < 16; ++i) { o[0][i] = 0.f; o[1][i] = 0.f; o[2][i] = 0.f; o[3][i] = 0.f; }
    LAS char* ldw = lds + wid * 1024;
    __syncthreads();
    for (int j = 0; j < NT; ++j) {
        const int cur = j & 1;
        if (j + 1 < NT) { const size_t go = (size_t)(j + 1) * 16384; LAS char* d = ldw + (cur ^ 1) * 32768; dma16(kimg + go, d); dma16(kimg + go + 8192, d + 8192); dma16(vimg + go, d + 16384); dma16(vimg + go + 8192, d + 24576); }
        const LAS char* kb = lds + cur * 32768 + c * 8192; const LAS char* vb = lds + cur * 32768 + 16384; const int k_lo = j * 64;
        if (k_lo <= qw + 31) {
            f32x16 p0, p1; qk_tile(p0, p1, kb, qr, r32, hi);
            const bool near = (qw - (k_lo + 63) < 128);
            int dbase = t_q - k_lo - 4 * hi; asm volatile("" : "+v"(dbase));
            lsum += softmax_tile<false>(p0, p1, lut, near, dbase);
            bf16x8 pa[4]; pack_p(p0, p1, pa);
            pv_tile<4>(o, vb, lane, hi, pa);
        }
        __syncthreads();
    }
    if (qb_next >= 0) diff_prime(lds, tid, b, h, qb_next, QO, KD, VD, qr);
    LAS float* wsf = (LAS float*)(lds + LDS_WSF2) + wid * 32;
    const float l = pair_sum(lsum);
    if (hi == 0) wsf[r32] = l;
    asm volatile("s_waitcnt lgkmcnt(0)" ::: "memory");
    float rl[16];
#pragma unroll
    for (int r = 0; r < 16; ++r) rl[r] = frcp(wsf[crow(r, hi)]);
    LAS float* X = (LAS float*)(lds + 65536) + (size_t)wq * 4096;
    if (c == 1) {
#pragma unroll
        for (int qd = 0; qd < 4; ++qd)
#pragma unroll
            for (int r = 0; r < 16; ++r) X[(qd * 16 + r) * 64 + lane] = o[qd][r] * rl[r] * lam;
    }
    __syncthreads();
    if (c == 0) {
        LAS bf16_t* stg = (LAS bf16_t*)(lds + 32768) + wq * 4096;
#pragma unroll
        for (int r = 0; r < 16; ++r) { float ss = 0.f;
#pragma unroll
            for (int qd = 0; qd < 4; ++qd) { const float v = o[qd][r] * rl[r] - X[(qd * 16 + r) * 64 + lane]; o[qd][r] = v; ss += v * v; }
            ss += __shfl_xor(ss, 1); ss += __shfl_xor(ss, 2); ss += __shfl_xor(ss, 4); ss += __shfl_xor(ss, 8); ss += __shfl_xor(ss, 16);
            const float nrm = oscale * frsq(ss * (1.0f / 128.0f) + EPS_); const int row = crow(r, hi);
#pragma unroll
            for (int qd = 0; qd < 4; ++qd) stg[row * 128 + qd * 32 + r32] = (bf16_t)(cvtpk(o[qd][r] * nrm * subg[qd * 32 + r32], 0.f) & 0xffffu); }
        asm volatile("s_waitcnt lgkmcnt(0)" ::: "memory");
#pragma unroll
        for (int i = 0; i < 8; ++i) { const int row = i * 4 + (lane >> 4), ch = lane & 15; *(u32x4*)(Qw + (size_t)row * 512 + ch * 8) = *(const LAS u32x4*)(stg + row * 128 + ch * 8); }
    }
    if (qb_next < 0) __syncthreads();
}

DI void swa_prime(LAS char* lds, int tid, int b, int hq, int qb, const bf16_t* QO, const unsigned char* KS, const unsigned char* VS, bf16x8 (&qr)[4]) {
    const int lane = tid & 63, r32 = lane & 31, hi = lane >> 5, wid = __builtin_amdgcn_readfirstlane(tid >> 6);
    const int qw = qb * 256 + wid * 32, kvh = hq >> 2;
    const bf16_t* Qw = QO + ((size_t)b * SEQ_ + qw) * 512 + hq * 64;
#pragma unroll
    for (int d0 = 0; d0 < 4; ++d0) qr[d0] = *(const bf16x8*)(Qw + (size_t)r32 * 512 + d0 * 16 + hi * 8);
    const unsigned char* kimg = KS + (size_t)((b * 2 + kvh) * 32) * 8192 + tid * 16; const unsigned char* vimg = VS + (size_t)((b * 2 + kvh) * 32) * 8192 + tid * 16;
    const int jlo = qb * 4 - 2 < 0 ? 0 : qb * 4 - 2, jhi = qb * 4 + 3; LAS char* ldw = lds + wid * 1024;
    for (int j = jlo; j <= jhi; ++j) { LAS char* d = ldw + (j - jlo) * 16384; dma16(kimg + (size_t)j * 8192, d); dma16(vimg + (size_t)j * 8192, d + 8192); }
}
DI void swa_unit(LAS char* lds, const LAS float* lut, int b, int hq, int qb, int qb_next, bf16x8 (&qr)[4], bf16_t* QO, const unsigned char* KS, const unsigned char* VS, float sink_term) {
    int tid_ = threadIdx.x; asm volatile("" : "+v"(tid_));
    const int tid = tid_, lane = tid & 63, r32 = lane & 31, hi = lane >> 5, wid = __builtin_amdgcn_readfirstlane(tid >> 6);
    const int q0 = qb * 256, qw = q0 + wid * 32; const size_t rowbase = (size_t)b * SEQ_;
    bf16_t* Qw = QO + (rowbase + qw) * 512 + hq * 64;
    const int jlo = qb * 4 - 2 < 0 ? 0 : qb * 4 - 2; const int t_q = qw + r32;
    float lsum = 0.f; f32x16 o[2];
#pragma unroll
    for (int i = 0; i < 16; ++i) { o[0][i] = 0.f; o[1][i] = 0.f; }
    __syncthreads();
    { int ja = (qw - 127) >> 6; if (ja < jlo) ja = jlo; const int jb = (qw + 31) >> 6;
      for (int j = ja; j <= jb; ++j) {
        const LAS char* kb = lds + (j - jlo) * 16384; const LAS char* vb = kb + 8192; const int k_lo = j * 64;
        f32x16 p0, p1; qk_tile(p0, p1, kb, qr, r32, hi);
        int dbase = t_q - k_lo - 4 * hi; asm volatile("" : "+v"(dbase));
        lsum += softmax_tile<true>(p0, p1, lut, true, dbase);
        bf16x8 pa[4]; pack_p(p0, p1, pa);
        pv_tile<2>(o, vb, lane, hi, pa);
      } }
    __syncthreads();
    if (qb_next >= 0) swa_prime(lds, tid, b, hq, qb_next, QO, KS, VS, qr);
    LAS float* wsf = (LAS float*)(lds + LDS_WSF2) + wid * 32;
    const float l = pair_sum(lsum) + sink_term;
    if (hi == 0) wsf[r32] = l;
    asm volatile("s_waitcnt lgkmcnt(0)" ::: "memory");
    {
        LAS bf16_t* stg = (LAS bf16_t*)(lds + 98304) + wid * 2048;
#pragma unroll
        for (int r = 0; r < 16; ++r) { const int row = crow(r, hi); const float rl = frcp(wsf[row]);
#pragma unroll
            for (int d0 = 0; d0 < 2; ++d0) stg[row * 64 + d0 * 32 + r32] = (bf16_t)(cvtpk(o[d0][r] * rl, 0.f) & 0xffffu); }
        asm volatile("s_waitcnt lgkmcnt(0)" ::: "memory");
#pragma unroll
        for (int i = 0; i < 4; ++i) { const int row = i * 8 + (lane >> 3), ch = lane & 7; *(u32x4*)(Qw + (size_t)row * 512 + ch * 8) = *(const LAS u32x4*)(stg + row * 64 + ch * 8); }
    }
}


DI unsigned f2bf(float f) { unsigned u = __builtin_bit_cast(unsigned, f); return (u + 0x7fffu + ((u >> 16) & 1u)) >> 16; }
DI unsigned pk2(float lo, float hi) { return f2bf(lo) | (f2bf(hi) << 16); }
DI void titem_load(const float* W, const float* gain, int N, int item, int lane, f32x4 (&v)[8], float (&gk)[8]) {
    const int nblk = N / 32, kb = item / nblk, nb = item - kb * nblk, k0 = 64 * kb, n0 = 32 * nb;
#pragma unroll
    for (int i = 0; i < 8; ++i) { const int kk = (lane >> 3) + 8 * i; v[i] = *(const f32x4*)(W + (size_t)(k0 + kk) * N + n0 + (lane & 7) * 4); gk[i] = gain ? gain[k0 + kk] : 1.0f; }
}
DI void titem_store(int K, int N, bf16_t* WT, LAS float* scr, int item, int lane, const f32x4 (&v)[8], const float (&gk)[8]) {
    const int nblk = N / 32, kb = item / nblk, nb = item - kb * nblk, k0 = 64 * kb, n0 = 32 * nb;
#pragma unroll
    for (int i = 0; i < 8; ++i) { const int kk = (lane >> 3) + 8 * i; LAS float* d = scr + kk * 33 + (lane & 7) * 4; const f32x4 x = v[i] * gk[i]; d[0] = x[0]; d[1] = x[1]; d[2] = x[2]; d[3] = x[3]; }
    asm volatile("s_waitcnt lgkmcnt(0)" ::: "memory");
    const int c = lane & 7;
#pragma unroll
    for (int j = 0; j < 4; ++j) { const int n = (lane >> 3) + 8 * j; const LAS float* s = scr + (8 * c) * 33 + n;
        u32x4 o; o.x = cvtpk(s[0 * 33], s[1 * 33]); o.y = cvtpk(s[2 * 33], s[3 * 33]); o.z = cvtpk(s[4 * 33], s[5 * 33]); o.w = cvtpk(s[6 * 33], s[7 * 33]);
        *(u32x4*)(WT + (size_t)(n0 + n) * K + k0 + 8 * c) = o; }
    asm volatile("s_waitcnt lgkmcnt(0)" ::: "memory");
}
DI int t5_bucket_dev(int n) { if (n < 16) return n; const float v = logf((float)n / 16.0f) / logf(8.0f) * 16.0f; const int bk = 16 + (int)v; return bk > 31 ? 31 : bk; }

typedef unsigned v4u_dummy_t;
#define XB_TMO      128
#define XB_XCNT(j)  (256  + 64 * (j))
#define XB_XSUB(j)  (1280 + 64 * (j))
#define XB_XGEN(j)  (2304 + 64 * (j))
#define XB_TOP      3328
#define XB_TOPGEN   3392
#define XCD_BAR_WORDS 3456
#define XB_SPIN_CAP (1u << 18)

__device__ __forceinline__ unsigned xb_ld(unsigned* p)              { return __hip_atomic_load(p, __ATOMIC_RELAXED, __HIP_MEMORY_SCOPE_AGENT); }
__device__ __forceinline__ unsigned xb_add(unsigned* p, unsigned v) { return __hip_atomic_fetch_add(p, v, __ATOMIC_RELAXED, __HIP_MEMORY_SCOPE_AGENT); }
__device__ __forceinline__ unsigned xb_xcc_id() { return (unsigned)__builtin_amdgcn_s_getreg((3 << 11) | 20) & 0xFu; }
#define XB_SPIN(cond, bar) do { unsigned _sp = 0; while (cond) { __builtin_amdgcn_s_sleep(1); \
    if ((++_sp & 255u) == 0u) { if (xb_ld(&(bar)[XB_TMO])) break; if (_sp > XB_SPIN_CAP) { atomicAdd(&(bar)[XB_TMO], 1u); break; } } } } while (0)

struct XcdBarrier {
    unsigned* bar; unsigned x;
    volatile LAS unsigned* st;
};

__device__ __forceinline__ XcdBarrier xcd_barrier_post(unsigned* bar, volatile LAS unsigned* st) {
    XcdBarrier b; b.bar = bar; b.x = xb_xcc_id(); b.st = st;
    if (threadIdx.x == 0) (void)xb_add(&bar[XB_XCNT(b.x)], 1u);
    return b;
}
__device__ __forceinline__ void xcd_barrier_complete(unsigned* bar, unsigned x, unsigned& nloc, unsigned& nx) {
    const unsigned G = gridDim.x * gridDim.y * gridDim.z;
    unsigned sum, cnt, mine, sp = 0u;
    for (;;) {
        sum = 0u; cnt = 0u; mine = 0u;
#pragma unroll
        for (unsigned j = 0; j < 16; ++j) { const unsigned c = xb_ld(&bar[XB_XCNT(j)]); sum += c; cnt += (c > 0u) ? 1u : 0u; mine = (j == x) ? c : mine; }
        if (sum == G) break;
        __builtin_amdgcn_s_sleep(1);
        if ((++sp & 255u) == 0u) { if (xb_ld(&bar[XB_TMO])) break; if (sp > XB_SPIN_CAP) { atomicAdd(&bar[XB_TMO], 1u); break; } }
    }
    nloc = mine > 0u ? mine : 1u; nx = cnt > 0u ? cnt : 1u;
}

__device__ __forceinline__ void xcd_barrier(const XcdBarrier& b) {
    asm volatile("s_waitcnt vmcnt(0)" ::: "memory");
    __syncthreads();
    if (threadIdx.x == 0) {
        unsigned* bar = b.bar; asm volatile("" : "+s"(bar));
        __builtin_amdgcn_s_waitcnt(0);
        unsigned nloc = b.st[0], nx = b.st[1];
        if (nloc == 0u) { xcd_barrier_complete(bar, b.x, nloc, nx); b.st[0] = nloc; b.st[1] = nx; }
        const unsigned old = xb_add(&bar[XB_XSUB(b.x)], 1u);
        const unsigned gen = old / nloc;
        if (old + 1u == (gen + 1u) * nloc) {
            __builtin_amdgcn_fence(__ATOMIC_RELEASE, "agent");
            asm volatile("s_waitcnt vmcnt(0)" ::: "memory");
            const unsigned og = xb_add(&bar[XB_TOP], 1u);
            const unsigned tg = og / nx;
            if (og + 1u == (tg + 1u) * nx) xb_add(&bar[XB_TOPGEN], 1u);
            else XB_SPIN(xb_ld(&bar[XB_TOPGEN]) == tg, bar);
            __builtin_amdgcn_fence(__ATOMIC_ACQUIRE, "agent");
            xb_add(&bar[XB_XGEN(b.x)], 1u);
            asm volatile("s_waitcnt vmcnt(0)" ::: "memory");
        } else {
            XB_SPIN(xb_ld(&bar[XB_XGEN(b.x)]) == gen, bar);
            __builtin_amdgcn_fence(__ATOMIC_ACQUIRE, "agent");
            asm volatile("s_waitcnt vmcnt(0)" ::: "memory");
        }
    }
    __syncthreads();
}

struct Args { const float* in[21]; float* out; unsigned char* ws; int ph_lo, ph_hi; };
enum { I_X = 0, I_F1N, I_F1WI, I_F1WO, I_MN, I_WIN, I_QND, I_KND, I_QNS, I_KNS, I_LAM, I_SUBLN, I_SINK, I_RELB, I_WPSB, I_WPD, I_WPSW, I_WOUT, I_F2N, I_F2WI, I_F2WO };
constexpr int N_PHASES = 19;

__global__ void __launch_bounds__(512, 2) mega_fwd(Args a) {
    extern __shared__ __attribute__((aligned(16))) unsigned char lds_raw[];
    LAS unsigned char* lds = (LAS unsigned char*)lds_raw;
    const int tid = threadIdx.x;
    LAS unsigned long long* ptab = (LAS unsigned long long*)(lds + LDS_PTAB);
    if (tid == 0) {
#pragma unroll
        for (int i = 0; i < 21; ++i) ptab[i] = (unsigned long long)(uintptr_t)a.in[i];
    }
    volatile LAS unsigned* barst = (volatile LAS unsigned*)(lds + LDS_BARST);
    if (tid == 0) { barst[0] = 0u; barst[1] = 0u; }
    __syncthreads();
    XcdBarrier xbar = xcd_barrier_post((unsigned*)(a.ws + WS_CTL), barst);
#define INP(i) ((const float*)(uintptr_t)rfl64(ptab[i]))
    for (int ph = a.ph_lo; ph < a.ph_hi; ++ph) {
        unsigned char* ws = a.ws; asm volatile("" : "+s"(ws));
        float* part = (float*)(ws + WS_PART);
        bf16_t* X1 = (bf16_t*)(ws + WS_X1); unsigned char* R = ws + WS_R; bf16_t* HID = (bf16_t*)(R + R_HID); bf16_t* XM = (bf16_t*)a.out;
        if (ph == 0) {
            int tid0 = threadIdx.x; asm volatile("" : "+v"(tid0)); const int lane = tid0 & 63, wave = __builtin_amdgcn_readfirstlane(tid0 >> 6);
            LAS float* scr = (LAS float*)(lds + wave * 16384);
            const int gw = blockIdx.x * 8 + wave, NGW = gridDim.x * 8;
            constexpr int IT_LAYER = 13184, IT_TOTAL = 2 * IT_LAYER;
#define TDECODE(g_, W, gain, WT, K, N, item) do { const int l_ = (g_) >= IT_LAYER ? 1 : 0; const int r_ = (g_) - l_ * IT_LAYER; unsigned char* wl_ = ws + WS_W + (size_t)l_ * W_LAYER; gain = nullptr; \
                if (r_ < 2816) { W = INP(I_F1WI) + (size_t)l_ * D_ * 2 * FF_; gain = INP(I_F1N) + l_ * D_; WT = (bf16_t*)(wl_ + W_1A); K = D_; N = 2 * FF_; item = r_; } \
                else if (r_ < 4224) { W = INP(I_F1WO) + (size_t)l_ * FF_ * D_; WT = (bf16_t*)(wl_ + W_2A); K = FF_; N = D_; item = r_ - 2816; } \
                else if (r_ < 7680) { W = INP(I_WIN) + (size_t)l_ * D_ * 6912; gain = INP(I_MN) + l_ * D_; WT = (bf16_t*)(wl_ + W_IN); K = D_; N = 6912; item = r_ - 4224; } \
                else if (r_ < 7936) { W = INP(I_WPSB) + (size_t)l_ * 512 * D_; WT = (bf16_t*)(wl_ + W_P); K = 512; N = D_; item = r_ - 7680; } \
                else if (r_ < 8192) { W = INP(I_WPD) + (size_t)l_ * 512 * D_; WT = (bf16_t*)(wl_ + W_P) + 512 * D_; K = 512; N = D_; item = r_ - 7936; } \
                else if (r_ < 8448) { W = INP(I_WPSW) + (size_t)l_ * 512 * D_; WT = (bf16_t*)(wl_ + W_P) + 2 * 512 * D_; K = 512; N = D_; item = r_ - 8192; } \
                else if (r_ < 8960) { W = INP(I_WOUT) + (size_t)l_ * D_ * D_; WT = (bf16_t*)(wl_ + W_O); K = D_; N = D_; item = r_ - 8448; } \
                else if (r_ < 11776) { W = INP(I_F2WI) + (size_t)l_ * D_ * 2 * FF_; gain = INP(I_F2N) + l_ * D_; WT = (bf16_t*)(wl_ + W_1B); K = D_; N = 2 * FF_; item = r_ - 8960; } \
                else { W = INP(I_F2WO) + (size_t)l_ * FF_ * D_; WT = (bf16_t*)(wl_ + W_2B); K = FF_; N = D_; item = r_ - 11776; } } while (0)
            if (gw < IT_TOTAL) {
                f32x4 tva[8], tvb[8]; float tga[8], tgb[8];
                const float *Wa, *ga, *Wb, *gb; bf16_t *WTa, *WTb; int Ka, Na, ia, Kb, Nb, ib;
                int g = gw;
                TDECODE(g, Wa, ga, WTa, Ka, Na, ia);
                titem_load(Wa, ga, Na, ia, lane, tva, tga);
                for (;;) {
                    int nx = g + NGW; { const int gq = nx < IT_TOTAL ? nx : IT_TOTAL - 1; TDECODE(gq, Wb, gb, WTb, Kb, Nb, ib); }
                    titem_load(Wb, gb, Nb, ib, lane, tvb, tgb);
                    titem_store(Ka, Na, WTa, scr, ia, lane, tva, tga); g = nx;
                    if (g >= IT_TOTAL) break;
                    nx = g + NGW; { const int gq = nx < IT_TOTAL ? nx : IT_TOTAL - 1; TDECODE(gq, Wa, ga, WTa, Ka, Na, ia); }
                    titem_load(Wa, ga, Na, ia, lane, tva, tga);
                    titem_store(Kb, Nb, WTb, scr, ib, lane, tvb, tgb); g = nx;
                    if (g >= IT_TOTAL) break;
                }
            }
#undef TDECODE
            const float* x = INP(I_X);
            for (int m0 = gw; m0 < M_; m0 += 2 * NGW) {
                f32x4 v[2][4];
#pragma unroll
                for (int u = 0; u < 2; ++u) { const int m = m0 + u * NGW; if (m < M_) { const f32x4* xr = (const f32x4*)(x + (size_t)m * D_) + lane;
#pragma unroll
                    for (int j = 0; j < 4; ++j) v[u][j] = xr[64 * j]; } }
#pragma unroll
                for (int u = 0; u < 2; ++u) { const int m = m0 + u * NGW; if (m < M_) { float s = 0.f;
#pragma unroll
                    for (int j = 0; j < 4; ++j) s += (v[u][j][0] * v[u][j][0] + v[u][j][1] * v[u][j][1]) + (v[u][j][2] * v[u][j][2] + v[u][j][3] * v[u][j][3]);
                    s = wave_sum(s);
                    unsigned long long* o8 = (unsigned long long*)(X1 + (size_t)m * D_) + lane;
#pragma unroll
                    for (int j = 0; j < 4; ++j) o8[64 * j] = (unsigned long long)cvtpk(v[u][j][0], v[u][j][1]) | ((unsigned long long)cvtpk(v[u][j][2], v[u][j][3]) << 32);
                    if (lane < 16) part[(size_t)m * 16 + lane] = lane == 0 ? s : 0.f; } }
            }
        } else {
            const int l = (ph - 1) / 9, k = (ph - 1) % 9; unsigned char* wl = ws + WS_W + (size_t)l * W_LAYER;
            const float lam_init = l == 0 ? 0.2f : (0.8f - 0.6f * 0.7408182206817179f);
            if (k == 0 || k == 7) {
                pg8::Gemm g{}; g.A0 = X1; g.B0 = (const bf16_t*)(wl + (k == 0 ? W_1A : W_1B)); g.K = D_; g.nM = 128; g.nN = 22; g.nbr = 1; g.b_tile_rows = 128; g.b_half_rows = FF_; g.b_spread = 0;
                pg8::EpiSwiglu E{HID, part};
                pg8::gemm_phase(lds, g, E);
            } else if (k == 1 || k == 8 || k == 6) {
                pg8::Gemm g{}; g.nM = 128; g.nN = 4; g.nbr = 1; g.b_tile_rows = 256; g.b_half_rows = 32; g.b_spread = 1;
                pg8::EpiRes E{};
                E.xb = X1; E.outf = nullptr; E.part = part; E.alpha = 0.5f;
                if (k == 1) { g.A0 = HID; g.B0 = (const bf16_t*)(wl + W_2A); g.K = FF_; }
                else if (k == 6) { g.A0 = XM; g.B0 = (const bf16_t*)(wl + W_O); g.K = D_; E.alpha = 1.0f; }
                else { g.A0 = HID; g.B0 = (const bf16_t*)(wl + W_2B); g.K = FF_; if (l == 1) E.outf = a.out; }
                pg8::gemm_phase(lds, g, E);
            } else if (k == 2) {
                pg8::Gemm g{}; g.A0 = X1; g.B0 = (const bf16_t*)(wl + W_IN); g.K = D_; g.nM = 128; g.nN = 15; g.nbr = 1; g.b_tile_rows = 256; g.b_half_rows = 32; g.b_spread = 1;
                pg8::EpiQKV E{part, R, INP(I_QND) + l * 64, INP(I_KND) + l * 64, INP(I_QNS) + l * 64, INP(I_KNS) + l * 64};
                pg8::gemm_phase(lds, g, E);
            } else if (k == 3) {
                LAS float* lut = (LAS float*)(lds + LDS_LUT); LAS float* misc = lut + 12 * 132;
                const float* relb = INP(I_RELB);
                int tid3 = threadIdx.x; asm volatile("" : "+v"(tid3));
                const int ln3 = tid3 & 63;
                float gqd = fabsf(INP(I_QND)[l * 64 + ln3]), gkd = fabsf(INP(I_KND)[l * 64 + ln3]), gqs = fabsf(INP(I_QNS)[l * 64 + ln3]), gks = fabsf(INP(I_KNS)[l * 64 + ln3]);
                const float* lv = INP(I_LAM) + l * 256;
                float d01 = lv[ln3] * lv[64 + ln3], d23 = lv[128 + ln3] * lv[192 + ln3];
#pragma unroll
                for (int o = 1; o < 64; o <<= 1) { gqd = fmaxf(gqd, __shfl_xor(gqd, o)); gkd = fmaxf(gkd, __shfl_xor(gkd, o)); gqs = fmaxf(gqs, __shfl_xor(gqs, o)); gks = fmaxf(gks, __shfl_xor(gks, o));
                    d01 += __shfl_xor(d01, o); d23 += __shfl_xor(d23, o); }
                const float lam = expf(d01) - expf(d23) + lam_init;
                if (tid3 < 12 * 32) {
                    const int head = tid3 >> 5; float mb = fabsf(relb[(tid3 & 31) * 12 + head]);
#pragma unroll
                    for (int o = 1; o < 32; o <<= 1) mb = fmaxf(mb, __shfl_xor(mb, o));
                    if ((tid3 & 31) == 0) misc[head] = (head < 4 ? 8.0f * gqd * gkd : 8.0f * gqs * gks) * 1.02f + mb; }
                __syncthreads();
                for (int e = tid3; e < 12 * 129; e += 512) { const int head = e / 129, d = e % 129;
                    lut[head * 132 + d] = (relb[t5_bucket_dev(d) * 12 + head] - misc[head]) * LOG2E_; }
                __syncthreads();
                for (int v0 = blockIdx.x; v0 < 256; v0 += gridDim.x) {
                    const int v = (v0 & 7) * 32 + (v0 >> 3);
                    { const int bh = v >> 1, b = bh >> 3, h = bh & 7;
                      bf16x8 qr[4]; { int t_ = threadIdx.x; asm volatile("" : "+v"(t_)); sb_prime((LAS char*)lds, t_, b, h, (v & 1) ? 1 : 0, (const bf16_t*)(R + R_QA), R + R_KA, R + R_VA, qr); }
                      for (int i = 0; i < 4; ++i) { const int od = v & 1; const int qb = od ? (i == 0 ? 1 : i == 1 ? 6 : i == 2 ? 3 : 4) : (i == 0 ? 0 : i == 1 ? 7 : i == 2 ? 2 : 5);
                          const int qn = i == 3 ? -1 : (od ? (i == 0 ? 6 : i == 1 ? 3 : 4) : (i == 0 ? 7 : i == 1 ? 2 : 5));
                          sb_unit((LAS char*)lds, b, h, qb, qn, qr, (bf16_t*)(R + R_QA), R + R_KA, R + R_VA); } }
                    { const int bh = v >> 2, b = bh >> 2, h = bh & 3, s = v & 3;
                      bf16x8 qr[4]; { int t_ = threadIdx.x; asm volatile("" : "+v"(t_)); diff_prime((LAS char*)lds, t_, b, h, s, (const bf16_t*)(R + R_QD), R + R_KD, R + R_VD, qr); }
                      for (int i = 0; i < 4; ++i) { const int qb = i == 0 ? s : i == 1 ? 7 - s : i == 2 ? 8 + s : 15 - s;
                          const int qn = i == 0 ? 7 - s : i == 1 ? 8 + s : i == 2 ? 15 - s : -1;
                          diff_unit((LAS char*)lds, lut + h * 132, b, h, qb, qn, qr, (bf16_t*)(R + R_QD), R + R_KD, R + R_VD, lam, INP(I_SUBLN) + l * 128, 1.0f - lam_init); } }
                    { bf16x8 qr[4]; const int un0 = v * 4, b = un0 >> 6, hq = (un0 >> 3) & 7;
                      const float sink_term = fexp2((INP(I_SINK)[l * 8 + hq] - misc[4 + hq]) * LOG2E_);
                      { int t_ = threadIdx.x; asm volatile("" : "+v"(t_)); swa_prime((LAS char*)lds, t_, b, hq, un0 & 7, (const bf16_t*)(R + R_QS), R + R_KS, R + R_VS, qr); }
                      for (int i = 0; i < 4; ++i) { const int qb = (un0 & 7) + i;
                        swa_unit((LAS char*)lds, lut + (4 + hq) * 132, b, hq, qb, i == 3 ? -1 : qb + 1, qr, (bf16_t*)(R + R_QS), R + R_KS, R + R_VS, sink_term); } }
                }
            } else if (k == 4) {
                pg8::Gemm g{}; g.A0 = X1; g.B0 = (const bf16_t*)(wl + W_IN) + (size_t)3840 * D_; g.K = D_; g.nM = 128; g.nN = 12; g.nbr = 1; g.b_tile_rows = 256; g.b_half_rows = 32; g.b_spread = 1;
                pg8::EpiGate E{part, (bf16_t*)(R + R_G)};
                pg8::gemm_phase(lds, g, E);
            } else {
                pg8::Gemm g{}; g.K = 512; g.nM = 128; g.nN = 4; g.nbr = 3; g.b_tile_rows = 256; g.b_half_rows = 32; g.b_spread = 1;
                g.A0 = (const bf16_t*)(R + R_QA); g.sA = 32 * MiB;
                g.B0 = (const bf16_t*)(wl + W_P); g.sB = (size_t)512 * D_ * 2;
                pg8::EpiMerge E{(const bf16_t*)(R + R_G), XM};
                pg8::gemm_phase(lds, g, E);
            }
        }
        if (ph + 1 < a.ph_hi) { if (a.ph_hi > 1000) cg::this_grid().sync(); else xcd_barrier(xbar); }
    }
}

extern "C" void kernel_launch(void* const* d_in, const int* in_sizes, int n_in, void* d_out, int out_size, void* d_ws, size_t ws_size, hipStream_t stream) {
    static int grid = 0;
    if (grid == 0) {
        if (n_in != 21 || in_sizes[0] != M_ * D_ || out_size != M_ * D_ || ws_size < WS_END) { fprintf(stderr, "kernel_launch: unexpected shapes / workspace (%d inputs, ws %zu)\n", n_in, ws_size); grid = -1; return; }
        int dev = 0, cus = 0, per_cu = 0;
        hipGetDevice(&dev); hipDeviceGetAttribute(&cus, hipDeviceAttributeMultiprocessorCount, dev);
        hipFuncSetAttribute((const void*)mega_fwd, hipFuncAttributeMaxDynamicSharedMemorySize, LDS_BYTES);
        if (hipOccupancyMaxActiveBlocksPerMultiprocessor(&per_cu, (const void*)mega_fwd, 512, LDS_BYTES) != hipSuccess || per_cu < 1) per_cu = 1;
        (void)hipGetLastError();
        grid = cus * 1;
        if (grid <= 0) grid = 256;
    }
    if (grid < 0) return;
    if (hipMemsetAsync((char*)d_ws + WS_CTL, 0, CTL_BYTES, stream) != hipSuccess) { fprintf(stderr, "kernel_launch: memset failed\n"); return; }
    Args a{};
    for (int i = 0; i < 21; ++i) a.in[i] = (const float*)d_in[i];
    a.out = (float*)d_out; a.ws = (unsigned char*)d_ws;
#if MK_PER_PHASE_LAUNCH
    for (int ph = 0; ph < N_PHASES; ++ph) { a.ph_lo = ph; a.ph_hi = ph + 1; hipLaunchKernelGGL(mega_fwd, dim3(grid), dim3(512), LDS_BYTES, stream, a); }
#else
    a.ph_lo = 0; a.ph_hi = N_PHASES;
    void* args[] = {&a};
    hipError_t e = hipLaunchCooperativeKernel((const void*)mega_fwd, dim3(grid), dim3(512), args, LDS_BYTES, stream);
    if (e != hipSuccess) fprintf(stderr, "cooperative launch failed: %s (grid %d)\n", hipGetErrorString(e), grid);
#endif
}
```

```cpp
#include <hip/hip_runtime.h>
#include <hip/hip_cooperative_groups.h>
#include <cstdio>
#include <cstdint>
namespace cg = cooperative_groups;

#ifndef MK_PER_PHASE_LAUNCH
#define MK_PER_PHASE_LAUNCH 0
#endif

#define LAS __attribute__((address_space(3)))
#define DI __device__ __forceinline__
typedef unsigned short bf16_t;
typedef short bf16x8 __attribute__((ext_vector_type(8)));
typedef short s16x4 __attribute__((ext_vector_type(4)));
typedef float f32x4 __attribute__((ext_vector_type(4)));
typedef float f32x16 __attribute__((ext_vector_type(16)));
typedef unsigned u32x4 __attribute__((ext_vector_type(4)));

constexpr int M_ = 32768, D_ = 1024, FF_ = 2816, SEQ_ = 2048;
constexpr float EPS_ = 1e-6f, LOG2E_ = 1.4426950408889634f, LN2_ = 0.6931471805599453f;
constexpr size_t MiB = (size_t)1 << 20;
constexpr size_t WS_PART = 0, WS_W = 2 * MiB, W_LAYER = 52 * MiB;
constexpr size_t W_1A = 0, W_2A = 11 * MiB, W_IN = 16 * MiB + MiB / 2, W_P = 30 * MiB, W_O = 33 * MiB, W_1B = 35 * MiB, W_2B = 46 * MiB;
constexpr size_t WS_X1 = 106 * MiB, WS_R = 170 * MiB, WS_CTL = 458 * MiB, CTL_BYTES = 65536, WS_END = 459 * MiB;
constexpr size_t R_QA = 0, R_QD = 32 * MiB, R_QS = 64 * MiB, R_KA = 96 * MiB, R_VA = 128 * MiB, R_KD = 160 * MiB, R_VD = 192 * MiB, R_KS = 224 * MiB, R_VS = 232 * MiB;
constexpr size_t R_G = 96 * MiB, R_HID = 0, R_X2 = 176 * MiB;
constexpr int LDS_BYTES = 147456, LDS_LUT = 131072, LDS_PTAB = 139264, LDS_BARST = 139776, LDS_FLG = 140288, LDS_WSF2 = 140416, LDS_OSTG = 67584;

DI unsigned cvtpk(float lo, float hi) { typedef float f2 __attribute__((ext_vector_type(2))); typedef __bf16 b2 __attribute__((ext_vector_type(2))); f2 v = {lo, hi}; b2 b = __builtin_convertvector(v, b2); return __builtin_bit_cast(unsigned, b); }
DI u32x4 pack8(f32x4 a, f32x4 b) { u32x4 w; w.x = cvtpk(a[0], a[1]); w.y = cvtpk(a[2], a[3]); w.z = cvtpk(b[0], b[1]); w.w = cvtpk(b[2], b[3]); return w; }
DI float bf2f(unsigned short h) { return __builtin_bit_cast(float, (unsigned)h << 16); }
DI void unpack8(u32x4 w, f32x4& a, f32x4& b) {
    a[0] = __builtin_bit_cast(float, w.x << 16); a[1] = __builtin_bit_cast(float, w.x & 0xffff0000u); a[2] = __builtin_bit_cast(float, w.y << 16); a[3] = __builtin_bit_cast(float, w.y & 0xffff0000u);
    b[0] = __builtin_bit_cast(float, w.z << 16); b[1] = __builtin_bit_cast(float, w.z & 0xffff0000u); b[2] = __builtin_bit_cast(float, w.w << 16); b[3] = __builtin_bit_cast(float, w.w & 0xffff0000u); }
DI unsigned long long rfl64(unsigned long long v) { const unsigned lo = __builtin_amdgcn_readfirstlane((unsigned)v), hi = __builtin_amdgcn_readfirstlane((unsigned)(v >> 32)); return ((unsigned long long)hi << 32) | lo; }
DI float fexp2(float x) { return __builtin_amdgcn_exp2f(x); }
DI float flog2(float x) { return __builtin_amdgcn_logf(x); }
DI float frcp(float x) { return __builtin_amdgcn_rcpf(x); }
DI float frsq(float x) { return __builtin_amdgcn_rsqf(x); }
DI float sigmoidf_(float x) { return frcp(1.0f + fexp2(-x * LOG2E_)); }
DI float psum32(float v) { float a = v, b = v; asm volatile("s_nop 1\n\tv_permlane32_swap_b32 %0, %1" : "+v"(a), "+v"(b)); return a + b; }
DI float wave_sum(float v) {
#pragma unroll
    for (int o = 1; o < 64; o <<= 1) v += __shfl_xor(v, o);
    return v; }

namespace pg8 {
constexpr int BM = 256, BK = 64, HALF = 128, HTB = HALF * BK * 2, STAGE_BYTES = 8 * HTB, NXCD = 8, WGM = 8;
DI int lds_byte(int r, int c) { const int st = (r >> 4) * 2 + (c >> 5), rr = r & 15, cc = c & 31, ob = rr * 64 + cc * 2; return st * 1024 + (ob ^ (((ob >> 9) & 1) << 5)); }
DI void stage_rc(int b, int& R, int& C) { const int st = b / 1024, sb = b % 1024, swz = sb ^ (((sb >> 9) & 1) << 5); R = (st >> 1) * 16 + swz / 64; C = (st & 1) * 32 + (swz % 64) / 2; }
DI int perm32(int rho) { const int n = rho >> 4, i = rho & 15; return 8 * (i >> 2) + 4 * n + (i & 3); }

struct Unit { int pm, pn, br; };
struct Gemm { const bf16_t *A0, *B0; size_t sA, sB; int K, nM, nN, nbr, b_tile_rows, b_half_rows, b_spread; };
DI const char* selA(const Gemm& g, int br) { return (const char*)g.A0 + (size_t)br * g.sA; }
DI const char* selB(const Gemm& g, int br) { return (const char*)g.B0 + (size_t)br * g.sB; }

DI bool next_unit(const Gemm& g, int i, Unit& u) {
    const int G = gridDim.x, c = blockIdx.x; const int nM = g.nM, nN = g.nN, nwg = nM * nN;
    const int ti = i / g.nbr; u.br = i - ti * g.nbr;
    const long L = (long)ti * G + c; if (L >= nwg) return false;
    int wgid = (int)L; { const int q = nwg / NXCD, r = nwg % NXCD, xcd = wgid % NXCD, off = wgid / NXCD; wgid = (xcd < r ? xcd * (q + 1) : r * (q + 1) + (xcd - r) * q) + off; }
    const int nig = WGM * nN, gid = wgid / nig, fm = gid * WGM, gsz = (nM - fm) < WGM ? (nM - fm) : WGM;
    u.pm = fm + ((wgid % nig) % gsz); u.pn = (wgid % nig) / gsz; return true;
}

template <class Epi>
DI void gemm_phase(LAS unsigned char* lds, const Gemm& g, const Epi& E) {
    int tid_ = threadIdx.x; asm volatile("" : "+v"(tid_));
    const int tid = tid_, wid = __builtin_amdgcn_readfirstlane(tid >> 6), lane = tid & 63, wr = wid >> 2, wc = wid & 3, fr = lane & 15, fq = lane >> 4;
    const int K = g.K, nt = K / BK;
    unsigned voffA[2], voffB[2];
#pragma unroll
    for (int i = 0; i < 2; ++i) { int R, C; stage_rc(tid * 16 + i * 8192, R, C); int Rb = (R & ~31) + perm32(R & 31); if (g.b_spread) Rb = ((Rb >> 5) << 6) + (Rb & 31);
        voffA[i] = (unsigned)(R * K + C) * 2u; voffB[i] = (unsigned)(Rb * K + C) * 2u; }
    const size_t kstep = (size_t)(BK * 2);
    const size_t hA = (size_t)HALF * K * 2, hB = (size_t)g.b_half_rows * K * 2;
    const size_t tA = (size_t)BM * K * 2, tB = (size_t)g.b_tile_rows * K * 2;
    const unsigned ldsw = (unsigned)wid * 1024u;
    const int aoff = lds_byte(wr * 64 + fr, fq * 8), boff = lds_byte(wc * 32 + fr, fq * 8);
#define PG8_SA(b, h) (((b) * 2 + (h)) * HTB)
#define PG8_SB(b, h) ((4 + (b) * 2 + (h)) * HTB)
#define PG8_STAGE(bufoff, gbase, voff) do { _Pragma("unroll") for (int _i = 0; _i < 2; ++_i) \
        __builtin_amdgcn_global_load_lds((const unsigned*)((const char*)(gbase) + (voff)[_i]), (LAS unsigned*)(lds + (bufoff) + ldsw + _i * 8192), 16, 0, 0); } while (0)
#define PG8_LDA(dst, b, h) do { _Pragma("unroll") for (int m = 0; m < 4; ++m) _Pragma("unroll") for (int k = 0; k < 2; ++k) dst[m][k] = *(const LAS bf16x8*)(lds + PG8_SA(b, h) + aoff + m * 2048 + k * 1024); } while (0)
#define PG8_LDB(dst, b, h) do { _Pragma("unroll") for (int n = 0; n < 2; ++n) _Pragma("unroll") for (int k = 0; k < 2; ++k) dst[n][k] = *(const LAS bf16x8*)(lds + PG8_SB(b, h) + boff + n * 2048 + k * 1024); } while (0)
#define PG8_MMA(ai, bj, At, Bt) do { __builtin_amdgcn_s_setprio(1); _Pragma("unroll") for (int m = 0; m < 4; ++m) _Pragma("unroll") for (int n = 0; n < 2; ++n) _Pragma("unroll") for (int k = 0; k < 2; ++k) \
        acc[ai][bj][m][n] = __builtin_amdgcn_mfma_f32_16x16x32_bf16(Bt[n][k], At[m][k], acc[ai][bj][m][n], 0, 0, 0); __builtin_amdgcn_s_setprio(0); } while (0)
#define PG8_WAIT_V(n) asm volatile("s_waitcnt vmcnt(" #n ")" ::: "memory")
#define PG8_WAIT_L(n) asm volatile("s_waitcnt lgkmcnt(" #n ")" ::: "memory")
#define PG8_BAR __builtin_amdgcn_s_barrier()
#define PG8_SCHED __builtin_amdgcn_sched_barrier(0)
    Unit cur, nxt; int ui = 0;
    if (!next_unit(g, 0, cur)) return;
    f32x4 acc[2][2][4][2];
#pragma unroll
    for (int a = 0; a < 2; ++a)
#pragma unroll
        for (int b = 0; b < 2; ++b)
#pragma unroll
            for (int m = 0; m < 4; ++m)
#pragma unroll
                for (int n = 0; n < 2; ++n) acc[a][b][m][n] = (f32x4){0.f, 0.f, 0.f, 0.f};
    bf16x8 At[4][2], B0[2][2], B1[2][2];
    const char* cA = selA(g, cur.br) + (size_t)cur.pm * tA; const char* cB = selB(g, cur.br) + (size_t)cur.pn * tB;
    PG8_STAGE(PG8_SB(0, 0), cB, voffB); PG8_STAGE(PG8_SB(0, 1), cB + hB, voffB); PG8_STAGE(PG8_SA(0, 0), cA, voffA); PG8_STAGE(PG8_SA(0, 1), cA + hA, voffA);
    if (wr == 1) PG8_BAR;
    PG8_WAIT_V(2); PG8_BAR;
    PG8_STAGE(PG8_SB(1, 0), cB + kstep, voffB); PG8_STAGE(PG8_SA(1, 0), cA + kstep, voffA); PG8_STAGE(PG8_SB(1, 1), cB + hB + kstep, voffB);
    PG8_WAIT_V(6); PG8_BAR;
    for (;;) {
        const bool has_next = next_unit(g, ui + 1, nxt);
        const char* nA = has_next ? selA(g, nxt.br) + (size_t)nxt.pm * tA : cA; const char* nB = has_next ? selB(g, nxt.br) + (size_t)nxt.pn * tB : cB;
        for (int t = 0; t < nt; t += 2) {
            const bool last = (t == nt - 2);
            const char* a1 = cA + (size_t)(t + 1) * kstep;
            const char* a2 = last ? nA : cA + (size_t)(t + 2) * kstep; const char* b2 = last ? nB : cB + (size_t)(t + 2) * kstep;
            const char* a3 = a2 + kstep; const char* b3 = b2 + kstep;
            PG8_LDB(B0, 0, 0); PG8_LDB(B1, 0, 1); PG8_SCHED; PG8_LDA(At, 0, 0); PG8_STAGE(PG8_SA(1, 1), a1 + hA, voffA);
            PG8_WAIT_V(8); PG8_WAIT_L(0); PG8_BAR; PG8_MMA(0, 0, At, B0); PG8_MMA(0, 1, At, B1); PG8_BAR; PG8_SCHED;
            PG8_LDA(At, 0, 1); PG8_STAGE(PG8_SB(0, 0), b2, voffB); PG8_STAGE(PG8_SB(0, 1), b2 + hB, voffB); PG8_STAGE(PG8_SA(0, 0), a2, voffA);
            PG8_WAIT_V(8); PG8_WAIT_L(0); PG8_BAR; PG8_MMA(1, 0, At, B0); PG8_MMA(1, 1, At, B1); PG8_BAR; PG8_SCHED;
            PG8_LDB(B0, 1, 0); PG8_LDB(B1, 1, 1); PG8_SCHED; PG8_LDA(At, 1, 0); PG8_STAGE(PG8_SA(0, 1), a2 + hA, voffA);
            PG8_WAIT_V(8); PG8_WAIT_L(0); PG8_BAR; PG8_MMA(0, 0, At, B0); PG8_MMA(0, 1, At, B1); PG8_BAR; PG8_SCHED;
            PG8_LDA(At, 1, 1); PG8_STAGE(PG8_SB(1, 0), b3, voffB); PG8_STAGE(PG8_SB(1, 1), b3 + hB, voffB); PG8_STAGE(PG8_SA(1, 0), a3, voffA);
            PG8_WAIT_V(8); PG8_WAIT_L(0); PG8_BAR; PG8_MMA(1, 0, At, B0); PG8_MMA(1, 1, At, B1); PG8_BAR; PG8_SCHED;
        }
        if (wr == 0) PG8_BAR;
        E(acc, cur, wr, wc, fr, fq);
        if (!has_next) break;
        if (!(Epi::CHAIN_BR && nxt.br != 0))
#pragma unroll
        for (int a = 0; a < 2; ++a)
#pragma unroll
            for (int b = 0; b < 2; ++b)
#pragma unroll
                for (int m = 0; m < 4; ++m)
#pragma unroll
                    for (int n = 0; n < 2; ++n) acc[a][b][m][n] = (f32x4){0.f, 0.f, 0.f, 0.f};
        cur = nxt; cA = nA; cB = nB; ++ui;
        if (wr == 1) PG8_BAR;
    }
    PG8_WAIT_V(0);
    PG8_BAR;
#undef PG8_SA
#undef PG8_SB
#undef PG8_STAGE
#undef PG8_LDA
#undef PG8_LDB
#undef PG8_MMA
#undef PG8_WAIT_V
#undef PG8_WAIT_L
#undef PG8_BAR
#undef PG8_SCHED
}

typedef f32x4 Acc[2][2][4][2];
DI void load_rstd(const float* part, int row0, int fq, float (&rs)[2][4]) {
#pragma unroll
    for (int ai = 0; ai < 2; ++ai)
#pragma unroll
        for (int m = 0; m < 4; ++m) { const f32x4 a = *(const f32x4*)(part + (size_t)(row0 + ai * HALF + m * 16) * 16 + fq * 4);
            float s = (a[0] + a[1]) + (a[2] + a[3]); s += __shfl_xor(s, 16); s = psum32(s);
            rs[ai][m] = frsq(s * (1.0f / 1024.0f) + EPS_); }
}

struct EpiSwiglu {
    static constexpr bool CHAIN_BR = false;
    bf16_t* H; const float* part;
    DI void operator()(const Acc& acc, const Unit& u, int wr, int wc, int fr, int fq) const {
        const int row0 = u.pm * BM + wr * 64 + fr, col0 = u.pn * 128 + wc * 32 + 8 * fq;
        float rs[2][4]; load_rstd(part, row0, fq, rs);
#pragma unroll
        for (int ai = 0; ai < 2; ++ai)
#pragma unroll
            for (int m = 0; m < 4; ++m) { const float r = rs[ai][m]; f32x4 h[2];
                const float rl = r * -LOG2E_, r2 = r * r;
#pragma unroll
                for (int n = 0; n < 2; ++n) { const f32x4 ga = acc[ai][0][m][n], ua = acc[ai][1][m][n];
#pragma unroll
                    for (int i = 0; i < 4; ++i) h[n][i] = (ga[i] * ua[i]) * (r2 * frcp(1.0f + fexp2(ga[i] * rl))); }
                *(u32x4*)(H + (size_t)(row0 + ai * HALF + m * 16) * FF_ + col0) = pack8(h[0], h[1]); }
    }
};
struct EpiRes {
    static constexpr bool CHAIN_BR = false;
    bf16_t* xb; float* outf; float* part; float alpha;
    DI void operator()(const Acc& acc, const Unit& u, int wr, int wc, int fr, int fq) const {
        const int row0 = u.pm * BM + wr * 64 + fr, col0 = u.pn * BM + wc * 64 + 8 * fq;
#pragma unroll
        for (int ai = 0; ai < 2; ++ai)
#pragma unroll
            for (int m = 0; m < 4; ++m) { const int r = row0 + ai * HALF + m * 16; float ss = 0.f;
#pragma unroll
                for (int bj = 0; bj < 2; ++bj) { const size_t off = (size_t)r * D_ + col0 + bj * 32;
                    f32x4 b0, b1; unpack8(*(const u32x4*)(xb + off), b0, b1);
                    const f32x4 v0 = b0 + acc[ai][bj][m][0] * alpha, v1 = b1 + acc[ai][bj][m][1] * alpha;
                    if (outf) { *(f32x4*)(outf + off) = v0; *(f32x4*)(outf + off + 4) = v1; }
                    else { *(u32x4*)(xb + off) = pack8(v0, v1);
                        ss += (v0[0] * v0[0] + v0[1] * v0[1]) + (v0[2] * v0[2] + v0[3] * v0[3]) + (v1[0] * v1[0] + v1[1] * v1[1]) + (v1[2] * v1[2] + v1[3] * v1[3]); } }
                if (!outf) { ss += __shfl_xor(ss, 16); ss = psum32(ss); if (fq == 0) part[(size_t)r * 16 + u.pn * 4 + wc] = ss; } }
    }
};
struct EpiQKV {
    static constexpr bool CHAIN_BR = false;
    const float* part; unsigned char* R; const float *gqd, *gkd, *gqs, *gks;
    DI void operator()(const Acc& acc, const Unit& u, int wr, int wc, int fr, int fq) const {
        const int L = u.pn * 256 + wc * 64; const int b = u.pm >> 3, t0 = (u.pm & 7) * 4 + wr;
        const int row0 = u.pm * BM + wr * 64 + fr;
        int kind; const float* gain = nullptr; size_t dsto; unsigned tstride = 8192;
        if (L < 512) { kind = 0; dsto = R_QA + (size_t)L * 2; }
        else if (L < 1024) { kind = 1; const int h = (L - 512) >> 6; dsto = R_KA + (size_t)((b * 8 + h) * 32) * 8192; }
        else if (L < 1536) { kind = 2; const int h = (L - 1024) >> 6; dsto = R_VA + (size_t)((b * 8 + h) * 32) * 8192; }
        else if (L < 2048) { kind = 0; gain = gqd; dsto = R_QD + (size_t)(L - 1536) * 2; }
        else if (L < 2560) { kind = 1; gain = gkd; const int idx = (L - 2048) >> 6; dsto = R_KD + (size_t)((b * 4 + (idx >> 1)) * 32) * 16384 + (idx & 1) * 8192; tstride = 16384; }
        else if (L < 3072) { kind = 2; const int idx = (L - 2560) >> 6; dsto = R_VD + (size_t)((b * 4 + (idx >> 1)) * 32) * 16384 + (idx & 1) * 8192; tstride = 16384; }
        else if (L < 3584) { kind = 0; gain = gqs; dsto = R_QS + (size_t)(L - 3072) * 2; }
        else if (L < 3712) { kind = 1; gain = gks; const int kvh = (L - 3584) >> 6; dsto = R_KS + (size_t)((b * 2 + kvh) * 32) * 8192; }
        else { kind = 2; const int kvh = (L - 3712) >> 6; dsto = R_VS + (size_t)((b * 2 + kvh) * 32) * 8192; }
        unsigned lane_off, sa, sm, sb;
        if (kind == 0) { lane_off = (unsigned)(row0 * 512 + 8 * fq) * 2u; sa = 128u * 512u * 2u; sm = 16u * 512u * 2u; sb = 64u; }
        else if (kind == 1) { lane_off = (unsigned)t0 * tstride + fq * 1024 + fr * 16; sa = 2u * tstride; sm = 256u; sb = 4096u; }
        else { lane_off = (unsigned)t0 * tstride + fr * 64 + fq * 16; sa = 2u * tstride; sm = 1024u; sb = 4096u; }
        unsigned char* pl = R + dsto + lane_off;
        const float qs = (kind == 0) ? 0.125f : 1.0f;
#pragma unroll
        for (int ai = 0; ai < 2; ++ai)
#pragma unroll
            for (int m = 0; m < 4; ++m) {
                const f32x4 s4 = *(const f32x4*)(part + (size_t)(row0 + ai * HALF + m * 16) * 16 + fq * 4);
                float sr = (s4[0] + s4[1]) + (s4[2] + s4[3]); sr += __shfl_xor(sr, 16); sr = psum32(sr);
                const float r = frsq(sr * (1.0f / 1024.0f) + EPS_);
                f32x4 v[2][2]; float ss = 0.f;
#pragma unroll
                for (int bj = 0; bj < 2; ++bj)
#pragma unroll
                    for (int n = 0; n < 2; ++n) { v[bj][n] = acc[ai][bj][m][n] * r; const f32x4 x = v[bj][n]; ss += (x[0] * x[0] + x[1] * x[1]) + (x[2] * x[2] + x[3] * x[3]); }
                float sc = qs;
                if (gain) { ss += __shfl_xor(ss, 16); ss = psum32(ss); sc *= frsq(ss * (1.0f / 64.0f) + EPS_);
#pragma unroll
                    for (int bj = 0; bj < 2; ++bj)
#pragma unroll
                        for (int n = 0; n < 2; ++n) v[bj][n] *= *(const f32x4*)(gain + 32 * bj + 8 * fq + 4 * n); }
#pragma unroll
                for (int bj = 0; bj < 2; ++bj) *(u32x4*)(pl + ai * sa + m * sm + bj * sb) = pack8(v[bj][0] * sc, v[bj][1] * sc);
                if (m == 3) asm volatile("" ::: "memory");
            }
    }
};
struct EpiGate {
    static constexpr bool CHAIN_BR = false;
    const float* part; bf16_t* G;
    DI void operator()(const Acc& acc, const Unit& u, int wr, int wc, int fr, int fq) const {
        const int row0 = u.pm * BM + wr * 64 + fr, col0 = (u.pn & 3) * BM + wc * 64 + 8 * fq; bf16_t* Gb = G + (size_t)(u.pn >> 2) * M_ * D_;
        float rs[2][4]; load_rstd(part, row0, fq, rs);
#pragma unroll
        for (int ai = 0; ai < 2; ++ai)
#pragma unroll
            for (int m = 0; m < 4; ++m) { const float r = rs[ai][m];
#pragma unroll
                for (int bj = 0; bj < 2; ++bj) { f32x4 h[2];
#pragma unroll
                    for (int n = 0; n < 2; ++n)
#pragma unroll
                        for (int i = 0; i < 4; ++i) h[n][i] = fminf(fexp2(acc[ai][bj][m][n][i] * (r * -LOG2E_)), 1048576.0f);
                    *(u32x4*)(Gb + (size_t)(row0 + ai * HALF + m * 16) * D_ + col0 + bj * 32) = pack8(h[0], h[1]); } }
    }
};
struct EpiMerge {
    static constexpr bool CHAIN_BR = true;
    const bf16_t* G; bf16_t* Mg;
    DI void operator()(Acc& acc, const Unit& u, int wr, int wc, int fr, int fq) const {
        const int row0 = u.pm * BM + wr * 64 + fr, col0 = u.pn * BM + wc * 64 + 8 * fq;
        const bf16_t* Ga = G + (size_t)u.br * M_ * D_; const bf16_t* Gn = Ga + (size_t)M_ * D_;
#pragma unroll
        for (int ai = 0; ai < 2; ++ai)
#pragma unroll
            for (int m = 0; m < 4; ++m)
#pragma unroll
                for (int bj = 0; bj < 2; ++bj) { const size_t off = (size_t)(row0 + ai * HALF + m * 16) * D_ + col0 + bj * 32;
                    f32x4 a0, a1; unpack8(*(const u32x4*)(Ga + off), a0, a1);
#pragma unroll
                    for (int i = 0; i < 4; ++i) { a0[i] = frcp(1.0f + a0[i]); a1[i] = frcp(1.0f + a1[i]); }
                    if (u.br < 2) { f32x4 n0, n1; unpack8(*(const u32x4*)(Gn + off), n0, n1);
                        acc[ai][bj][m][0] *= a0 * (n0 + 1.0f); acc[ai][bj][m][1] *= a1 * (n1 + 1.0f); }
                    else *(u32x4*)(Mg + off) = pack8(acc[ai][bj][m][0] * a0, acc[ai][bj][m][1] * a1); }
    }
};
}

DI int crow(int r, int hi) { return (r & 3) + 8 * (r >> 2) + 4 * hi; }
typedef short v4i16_t __attribute__((ext_vector_type(4)));
DI s16x4 vtr(const LAS char* p) { return __builtin_bit_cast(s16x4, __builtin_amdgcn_ds_read_tr16_b64_v4i16((LAS v4i16_t*)p)); }
#define MFMA32(a, b, c) __builtin_amdgcn_mfma_f32_32x32x16_bf16((a), (b), (c), 0, 0, 0)

DI void qk_tile(f32x16& p0, f32x16& p1, const LAS char* kb, const bf16x8 (&qr)[4], int r32, int hi) {
    const LAS char* kp = kb + hi * 1024 + r32 * 16;
#pragma unroll
    for (int i = 0; i < 16; ++i) { p0[i] = 0.f; p1[i] = 0.f; }
    bf16x8 kf[8];
#pragma unroll
    for (int d0 = 0; d0 < 4; ++d0) { kf[2 * d0] = *(const LAS bf16x8*)(kp + d0 * 2048); kf[2 * d0 + 1] = *(const LAS bf16x8*)(kp + d0 * 2048 + 512); }
    __builtin_amdgcn_s_setprio(1);
#pragma unroll
    for (int d0 = 0; d0 < 4; ++d0) { p0 = MFMA32(kf[2 * d0], qr[d0], p0); p1 = MFMA32(kf[2 * d0 + 1], qr[d0], p1); }
    __builtin_amdgcn_s_setprio(0);
}
DI void pack_p(const f32x16& p0, const f32x16& p1, bf16x8 (&pa)[4]) {
    u32x4 w;
    w.x = cvtpk(p0[0], p0[1]); w.y = cvtpk(p0[2], p0[3]); w.z = cvtpk(p0[4], p0[5]); w.w = cvtpk(p0[6], p0[7]); pa[0] = __builtin_bit_cast(bf16x8, w);
    w.x = cvtpk(p0[8], p0[9]); w.y = cvtpk(p0[10], p0[11]); w.z = cvtpk(p0[12], p0[13]); w.w = cvtpk(p0[14], p0[15]); pa[1] = __builtin_bit_cast(bf16x8, w);
    w.x = cvtpk(p1[0], p1[1]); w.y = cvtpk(p1[2], p1[3]); w.z = cvtpk(p1[4], p1[5]); w.w = cvtpk(p1[6], p1[7]); pa[2] = __builtin_bit_cast(bf16x8, w);
    w.x = cvtpk(p1[8], p1[9]); w.y = cvtpk(p1[10], p1[11]); w.z = cvtpk(p1[12], p1[13]); w.w = cvtpk(p1[14], p1[15]); pa[3] = __builtin_bit_cast(bf16x8, w);
}
template <int NQ> DI void pv_tile(f32x16 (&o)[NQ], const LAS char* vb, int lane, int hi, const bf16x8 (&pa)[4]) {
    const LAS char* vp = vb + ((lane >> 4) & 1) * 32 + (lane & 3) * 8 + (4 * hi + ((lane & 15) >> 2)) * 64;
    __builtin_amdgcn_s_setprio(1);
#pragma unroll
    for (int qd = 0; qd < NQ; ++qd)
#pragma unroll
        for (int s = 0; s < 4; ++s) { const s16x4 lo = vtr(vp + qd * 4096 + s * 1024), hh = vtr(vp + qd * 4096 + s * 1024 + 512);
            const bf16x8 f = (bf16x8){lo[0], lo[1], lo[2], lo[3], hh[0], hh[1], hh[2], hh[3]};
            o[qd] = MFMA32(pa[s], f, o[qd]); if (s == 3) __builtin_amdgcn_sched_barrier(0); }
    __builtin_amdgcn_s_setprio(0);
}
DI void dma16(const unsigned char* gsrc, LAS char* ldst_wave) { __builtin_amdgcn_global_load_lds((const unsigned*)gsrc, (LAS unsigned*)ldst_wave, 16, 0, 0); }
DI float pair_sum(float v) { float a = v, b = v; asm volatile("s_nop 1\n\tv_permlane32_swap_b32 %0, %1" : "+v"(a), "+v"(b)); return a + b; }

DI void sb_prime(LAS char* lds, int tid, int b, int h, int qb, const bf16_t* QO, const unsigned char* KA, const unsigned char* VA, bf16x8 (&qr)[4]) {
    const int lane = tid & 63, r32 = lane & 31, hi = lane >> 5, wid = __builtin_amdgcn_readfirstlane(tid >> 6);
    const int q0 = qb * 256, qw = q0 + wid * 32;
    const bf16_t* Qw = QO + ((size_t)b * SEQ_ + qw) * 512 + h * 64;
#pragma unroll
    for (int d0 = 0; d0 < 4; ++d0) qr[d0] = *(const bf16x8*)(Qw + (size_t)r32 * 512 + d0 * 16 + hi * 8);
    const unsigned char* kimg = KA + (size_t)((b * 8 + h) * 32) * 8192 + tid * 16; const unsigned char* vimg = VA + (size_t)((b * 8 + h) * 32) * 8192 + tid * 16;
    const int T0 = q0 >> 6; LAS char* ldw = lds + wid * 1024;
#pragma unroll
    for (int k = 0; k < 4; ++k) { const int tj = T0 + k; LAS char* d = ldw + (tj % 6) * 16384; dma16(kimg + (size_t)tj * 8192, d); dma16(vimg + (size_t)tj * 8192, d + 8192); }
}
DI void sb_unit(LAS char* lds, int b, int h, int qb, int qb_next, bf16x8 (&qr)[4], bf16_t* QO, const unsigned char* KA, const unsigned char* VA) {
    int tid_ = threadIdx.x; asm volatile("" : "+v"(tid_));
    const int tid = tid_, lane = tid & 63, r32 = lane & 31, hi = lane >> 5, wid = __builtin_amdgcn_readfirstlane(tid >> 6);
    const int q0 = qb * 256, qw = q0 + wid * 32; const size_t rowbase = (size_t)b * SEQ_;
    bf16_t* Qw = QO + (rowbase + qw) * 512 + h * 64;
    const unsigned char* kimg = KA + (size_t)((b * 8 + h) * 32) * 8192 + tid * 16; const unsigned char* vimg = VA + (size_t)((b * 8 + h) * 32) * 8192 + tid * 16;
    const int t_q = qw + r32;
    float carry = 0.f; f32x16 o[2];
#pragma unroll
    for (int i = 0; i < 16; ++i) { o[0][i] = 0.f; o[1][i] = 0.f; }
    const int T0 = q0 >> 6;
    const int dj = (qw + 30) >> 6;
    LAS char* ldw = lds + wid * 1024;
    LAS unsigned* flg = (LAS unsigned*)(lds + LDS_FLG);
    __syncthreads();
    for (int it = 0; it <= T0 + 3; ++it) {
        bool wdone = true;
        { const int tn = T0 - it - 1; if (tn >= 0) { LAS char* d = ldw + (tn % 6) * 16384; dma16(kimg + (size_t)tn * 8192, d); dma16(vimg + (size_t)tn * 8192, d + 8192); } }
        const int j = dj - it;
        if (j >= 0) {
            const LAS char* kb = lds + (j % 6) * 16384; const LAS char* vb = kb + 8192; const int k_lo = j * 64;
            f32x16 p0, p1; qk_tile(p0, p1, kb, qr, r32, hi);
            const bool need_mask = (k_lo + 63 >= qw);
            int dbase = t_q - k_lo - 4 * hi; asm volatile("" : "+v"(dbase));
            f32x16 l0, l1;
#pragma unroll
            for (int r = 0; r < 16; ++r) {
                { const float z = p0[r]; const float e = fexp2(-fabsf(z) * LOG2E_); float lf = -(fmaxf(z, 0.f) + LN2_ * flog2(1.0f + e)); if (need_mask && (dbase - ((r & 3) + 8 * (r >> 2)) <= 0)) lf = 0.f; l0[r] = lf; }
                { const float z = p1[r]; const float e = fexp2(-fabsf(z) * LOG2E_); float lf = -(fmaxf(z, 0.f) + LN2_ * flog2(1.0f + e)); if (need_mask && (dbase - (32 + (r & 3) + 8 * (r >> 2)) <= 0)) lf = 0.f; l1[r] = lf; }
            }
            float own[8], P[8];
#pragma unroll
            for (int g = 0; g < 4; ++g) { own[g] = (l0[4 * g] + l0[4 * g + 1]) + (l0[4 * g + 2] + l0[4 * g + 3]); own[4 + g] = (l1[4 * g] + l1[4 * g + 1]) + (l1[4 * g + 2] + l1[4 * g + 3]); }
#pragma unroll
            for (int g = 0; g < 8; ++g) P[g] = pair_sum(own[g]);
            float suf = carry;
#pragma unroll
            for (int g = 7; g >= 0; --g) {
                float bt = suf + (hi == 0 ? (P[g] - own[g]) : 0.f);
#pragma unroll
                for (int i = 3; i >= 0; --i) { const int idx = 4 * (g & 3) + i;
                    if (g < 4) { const float lf = l0[idx]; float w = fexp2((p0[idx] + lf + bt) * LOG2E_); if (need_mask && (dbase - ((idx & 3) + 8 * (idx >> 2)) <= 0)) w = 0.f; p0[idx] = w; bt += lf; }
                    else { const float lf = l1[idx]; float w = fexp2((p1[idx] + lf + bt) * LOG2E_); if (need_mask && (dbase - (32 + (idx & 3) + 8 * (idx >> 2)) <= 0)) w = 0.f; p1[idx] = w; bt += lf; } }
                suf += P[g];
            }
            carry = suf;
            bf16x8 pa[4]; pack_p(p0, p1, pa);
            pv_tile<2>(o, vb, lane, hi, pa);
            wdone = (j == 0) || (__all(carry < -30.0f) != 0);
        }
        if (lane == 0) flg[(it & 1) * 8 + wid] = wdone ? 1u : 0u;
        __syncthreads();
        { const LAS u32x4* f4 = (const LAS u32x4*)(flg + (it & 1) * 8); const u32x4 fa = f4[0], fb = f4[1];
          if ((fa.x & fa.y & fa.z & fa.w & fb.x & fb.y & fb.z & fb.w) != 0u) break; }
    }
    if (qb_next >= 0) sb_prime(lds, tid, b, h, qb_next, QO, KA, VA, qr);
    {
        LAS bf16_t* stg = (LAS bf16_t*)(lds + 98304) + wid * 2048;
#pragma unroll
        for (int r = 0; r < 16; ++r) { const int row = crow(r, hi);
#pragma unroll
            for (int d0 = 0; d0 < 2; ++d0) stg[row * 64 + d0 * 32 + r32] = (bf16_t)(cvtpk(o[d0][r], 0.f) & 0xffffu); }
        asm volatile("s_waitcnt lgkmcnt(0)" ::: "memory");
#pragma unroll
        for (int i = 0; i < 4; ++i) { const int row = i * 8 + (lane >> 3), ch = lane & 7; *(u32x4*)(Qw + (size_t)row * 512 + ch * 8) = *(const LAS u32x4*)(stg + row * 64 + ch * 8); }
        asm volatile("s_waitcnt lgkmcnt(0)" ::: "memory");
    }
}


template <bool WINDOW> DI float softmax_tile(f32x16& p0, f32x16& p1, const LAS float* lut, bool near, int dbase  ) {
    float s = 0.f;
    if (!near) { const float c = lut[128];
#pragma unroll
        for (int r = 0; r < 16; ++r) { p0[r] = fexp2(p0[r] * LOG2E_ + c); p1[r] = fexp2(p1[r] * LOG2E_ + c); s += p0[r] + p1[r]; }
    } else {
#pragma unroll
        for (int r = 0; r < 16; ++r) {
            { const int dist = dbase - ((r & 3) + 8 * (r >> 2)); const int idx = dist < 0 ? 0 : (dist > 128 ? 128 : dist); float w = fexp2(p0[r] * LOG2E_ + lut[idx]); if (dist < 0 || (WINDOW && dist >= 128)) w = 0.f; p0[r] = w; s += w; }
            { const int dist = dbase - (32 + (r & 3) + 8 * (r >> 2)); const int idx = dist < 0 ? 0 : (dist > 128 ? 128 : dist); float w = fexp2(p1[r] * LOG2E_ + lut[idx]); if (dist < 0 || (WINDOW && dist >= 128)) w = 0.f; p1[r] = w; s += w; }
            if (r == 7) __builtin_amdgcn_sched_barrier(0);
        }
    }
    return s;
}

DI void diff_prime(LAS char* lds, int tid, int b, int h, int qb, const bf16_t* QO, const unsigned char* KD, const unsigned char* VD, bf16x8 (&qr)[4]) {
    const int lane = tid & 63, r32 = lane & 31, hi = lane >> 5, wid = __builtin_amdgcn_readfirstlane(tid >> 6);
    const int c = wid >> 2, wq = wid & 3, qw = qb * 128 + wq * 32;
    const bf16_t* Qw = QO + ((size_t)b * SEQ_ + qw) * 512 + h * 128;
#pragma unroll
    for (int d0 = 0; d0 < 4; ++d0) qr[d0] = *(const bf16x8*)(Qw + (size_t)r32 * 512 + c * 64 + d0 * 16 + hi * 8);
    const unsigned char* kimg = KD + (size_t)((b * 4 + h) * 32) * 16384 + tid * 16; const unsigned char* vimg = VD + (size_t)((b * 4 + h) * 32) * 16384 + tid * 16;
    LAS char* ldw = lds + wid * 1024;
    dma16(kimg, ldw); dma16(kimg + 8192, ldw + 8192); dma16(vimg, ldw + 16384); dma16(vimg + 8192, ldw + 24576);
}
DI void diff_unit(LAS char* lds, const LAS float* lut, int b, int h, int qb, int qb_next, bf16x8 (&qr)[4], bf16_t* QO, const unsigned char* KD, const unsigned char* VD, float lam, const float* subg, float oscale) {
    int tid_ = threadIdx.x; asm volatile("" : "+v"(tid_));
    const int tid = tid_, lane = tid & 63, r32 = lane & 31, hi = lane >> 5, wid = __builtin_amdgcn_readfirstlane(tid >> 6);
    const int c = wid >> 2, wq = wid & 3, q0 = qb * 128, qw = q0 + wq * 32; const size_t rowbase = (size_t)b * SEQ_;
    bf16_t* Qw = QO + (rowbase + qw) * 512 + h * 128;
    const unsigned char* kimg = KD + (size_t)((b * 4 + h) * 32) * 16384 + tid * 16; const unsigned char* vimg = VD + (size_t)((b * 4 + h) * 32) * 16384 + tid * 16;
    const int NT = (q0 + 128) / 64; const int t_q = qw + r32;
    float lsum = 0.f; f32x16 o[4];
#pragma unroll
    for (int i = 0; i < 16; ++i) { o[0][i] = 0.f; o[1][i] = 0.f; o[2][i] = 0.f; o[3][i] = 0.f; }
    LAS char* ldw = lds + wid * 1024;
    __syncthreads();
    for (int j = 0; j < NT; ++j) {
        const int cur = j & 1;
        if (j + 1 < NT) { const size_t go = (size_t)(j + 1) * 16384; LAS char* d = ldw + (cur ^ 1) * 32768; dma16(kimg + go, d); dma16(kimg + go + 8192, d + 8192); dma16(vimg + go, d + 16384); dma16(vimg + go + 8192, d + 24576); }
        const LAS char* kb = lds + cur * 32768 + c * 8192; const LAS char* vb = lds + cur * 32768 + 16384; const int k_lo = j * 64;
        if (k_lo <= qw + 31) {
            f32x16 p0, p1; qk_tile(p0, p1, kb, qr, r32, hi);
            const bool near = (qw - (k_lo + 63) < 128);
            int dbase = t_q - k_lo - 4 * hi; asm volatile("" : "+v"(dbase));
            lsum += softmax_tile<false>(p0, p1, lut, near, dbase);
            bf16x8 pa[4]; pack_p(p0, p1, pa);
            pv_tile<4>(o, vb, lane, hi, pa);
        }
        __syncthreads();
    }
    if (qb_next >= 0) diff_prime(lds, tid, b, h, qb_next, QO, KD, VD, qr);
    LAS float* wsf = (LAS float*)(lds + LDS_WSF2) + wid * 32;
    const float l = pair_sum(lsum);
    if (hi == 0) wsf[r32] = l;
    asm volatile("s_waitcnt lgkmcnt(0)" ::: "memory");
    float rl[16];
#pragma unroll
    for (int r = 0; r < 16; ++r) rl[r] = frcp(wsf[crow(r, hi)]);
    LAS float* X = (LAS float*)(lds + 65536) + (size_t)wq * 4096;
    if (c == 1) {
#pragma unroll
        for (int qd = 0; qd < 4; ++qd)
#pragma unroll
            for (int r = 0; r < 16; ++r) X[(qd * 16 + r) * 64 + lane] = o[qd][r] * rl[r] * lam;
    }
    __syncthreads();
    if (c == 0) {
        LAS bf16_t* stg = (LAS bf16_t*)(lds + 32768) + wq * 4096;
#pragma unroll
        for (int r = 0; r < 16; ++r) { float ss = 0.f;
#pragma unroll
            for (int qd = 0; qd < 4; ++qd) { const float v = o[qd][r] * rl[r] - X[(qd * 16 + r) * 64 + lane]; o[qd][r] = v; ss += v * v; }
            ss += __shfl_xor(ss, 1); ss += __shfl_xor(ss, 2); ss += __shfl_xor(ss, 4); ss += __shfl_xor(ss, 8); ss += __shfl_xor(ss, 16);
            const float nrm = oscale * frsq(ss * (1.0f / 128.0f) + EPS_); const int row = crow(r, hi);
#pragma unroll
            for (int qd = 0; qd < 4; ++qd) stg[row * 128 + qd * 32 + r32] = (bf16_t)(cvtpk(o[qd][r] * nrm * subg[qd * 32 + r32], 0.f) & 0xffffu); }
        asm volatile("s_waitcnt lgkmcnt(0)" ::: "memory");
#pragma unroll
        for (int i = 0; i < 8; ++i) { const int row = i * 4 + (lane >> 4), ch = lane & 15; *(u32x4*)(Qw + (size_t)row * 512 + ch * 8) = *(const LAS u32x4*)(stg + row * 128 + ch * 8); }
    }
    if (qb_next < 0) __syncthreads();
}

DI void swa_prime(LAS char* lds, int tid, int b, int hq, int qb, const bf16_t* QO, const unsigned char* KS, const unsigned char* VS, bf16x8 (&qr)[4]) {
    const int lane = tid & 63, r32 = lane & 31, hi = lane >> 5, wid = __builtin_amdgcn_readfirstlane(tid >> 6);
    const int qw = qb * 256 + wid * 32, kvh = hq >> 2;
    const bf16_t* Qw = QO + ((size_t)b * SEQ_ + qw) * 512 + hq * 64;
#pragma unroll
    for (int d0 = 0; d0 < 4; ++d0) qr[d0] = *(const bf16x8*)(Qw + (size_t)r32 * 512 + d0 * 16 + hi * 8);
    const unsigned char* kimg = KS + (size_t)((b * 2 + kvh) * 32) * 8192 + tid * 16; const unsigned char* vimg = VS + (size_t)((b * 2 + kvh) * 32) * 8192 + tid * 16;
    const int jlo = qb * 4 - 2 < 0 ? 0 : qb * 4 - 2, jhi = qb * 4 + 3; LAS char* ldw = lds + wid * 1024;
    for (int j = jlo; j <= jhi; ++j) { LAS char* d = ldw + (j - jlo) * 16384; dma16(kimg + (size_t)j * 8192, d); dma16(vimg + (size_t)j * 8192, d + 8192); }
}
DI void swa_unit(LAS char* lds, const LAS float* lut, int b, int hq, int qb, int qb_next, bf16x8 (&qr)[4], bf16_t* QO, const unsigned char* KS, const unsigned char* VS, float sink_term) {
    int tid_ = threadIdx.x; asm volatile("" : "+v"(tid_));
    const int tid = tid_, lane = tid & 63, r32 = lane & 31, hi = lane >> 5, wid = __builtin_amdgcn_readfirstlane(tid >> 6);
    const int q0 = qb * 256, qw = q0 + wid * 32; const size_t rowbase = (size_t)b * SEQ_;
    bf16_t* Qw = QO + (rowbase + qw) * 512 + hq * 64;
    const int jlo = qb * 4 - 2 < 0 ? 0 : qb * 4 - 2; const int t_q = qw + r32;
    float lsum = 0.f; f32x16 o[2];
#pragma unroll
    for (int i = 0; i < 16; ++i) { o[0][i] = 0.f; o[1][i] = 0.f; }
    __syncthreads();
    { int ja = (qw - 127) >> 6; if (ja < jlo) ja = jlo; const int jb = (qw + 31) >> 6;
      for (int j = ja; j <= jb; ++j) {
        const LAS char* kb = lds + (j - jlo) * 16384; const LAS char* vb = kb + 8192; const int k_lo = j * 64;
        f32x16 p0, p1; qk_tile(p0, p1, kb, qr, r32, hi);
        int dbase = t_q - k_lo - 4 * hi; asm volatile("" : "+v"(dbase));
        lsum += softmax_tile<true>(p0, p1, lut, true, dbase);
        bf16x8 pa[4]; pack_p(p0, p1, pa);
        pv_tile<2>(o, vb, lane, hi, pa);
      } }
    __syncthreads();
    if (qb_next >= 0) swa_prime(lds, tid, b, hq, qb_next, QO, KS, VS, qr);
    LAS float* wsf = (LAS float*)(lds + LDS_WSF2) + wid * 32;
    const float l = pair_sum(lsum) + sink_term;
    if (hi == 0) wsf[r32] = l;
    asm volatile("s_waitcnt lgkmcnt(0)" ::: "memory");
    {
        LAS bf16_t* stg = (LAS bf16_t*)(lds + 98304) + wid * 2048;
#pragma unroll
        for (int r = 0; r < 16; ++r) { const int row = crow(r, hi); const float rl = frcp(wsf[row]);
#pragma unroll
            for (int d0 = 0; d0 < 2; ++d0) stg[row * 64 + d0 * 32 + r32] = (bf16_t)(cvtpk(o[d0][r] * rl, 0.f) & 0xffffu); }
        asm volatile("s_waitcnt lgkmcnt(0)" ::: "memory");
#pragma unroll
        for (int i = 0; i < 4; ++i) { const int row = i * 8 + (lane >> 3), ch = lane & 7; *(u32x4*)(Qw + (size_t)row * 512 + ch * 8) = *(const LAS u32x4*)(stg + row * 64 + ch * 8); }
    }
}


DI unsigned f2bf(float f) { unsigned u = __builtin_bit_cast(unsigned, f); return (u + 0x7fffu + ((u >> 16) & 1u)) >> 16; }
DI unsigned pk2(float lo, float hi) { return f2bf(lo) | (f2bf(hi) << 16); }
DI void titem_load(const float* W, const float* gain, int N, int item, int lane, f32x4 (&v)[8], float (&gk)[8]) {
    const int nblk = N / 32, kb = item / nblk, nb = item - kb * nblk, k0 = 64 * kb, n0 = 32 * nb;
#pragma unroll
    for (int i = 0; i < 8; ++i) { const int kk = (lane >> 3) + 8 * i; v[i] = *(const f32x4*)(W + (size_t)(k0 + kk) * N + n0 + (lane & 7) * 4); gk[i] = gain ? gain[k0 + kk] : 1.0f; }
}
DI void titem_store(int K, int N, bf16_t* WT, LAS float* scr, int item, int lane, const f32x4 (&v)[8], const float (&gk)[8]) {
    const int nblk = N / 32, kb = item / nblk, nb = item - kb * nblk, k0 = 64 * kb, n0 = 32 * nb;
#pragma unroll
    for (int i = 0; i < 8; ++i) { const int kk = (lane >> 3) + 8 * i; LAS float* d = scr + kk * 33 + (lane & 7) * 4; const f32x4 x = v[i] * gk[i]; d[0] = x[0]; d[1] = x[1]; d[2] = x[2]; d[3] = x[3]; }
    asm volatile("s_waitcnt lgkmcnt(0)" ::: "memory");
    const int c = lane & 7;
#pragma unroll
    for (int j = 0; j < 4; ++j) { const int n = (lane >> 3) + 8 * j; const LAS float* s = scr + (8 * c) * 33 + n;
        u32x4 o; o.x = cvtpk(s[0 * 33], s[1 * 33]); o.y = cvtpk(s[2 * 33], s[3 * 33]); o.z = cvtpk(s[4 * 33], s[5 * 33]); o.w = cvtpk(s[6 * 33], s[7 * 33]);
        *(u32x4*)(WT + (size_t)(n0 + n) * K + k0 + 8 * c) = o; }
    asm volatile("s_waitcnt lgkmcnt(0)" ::: "memory");
}
DI int t5_bucket_dev(int n) { if (n < 16) return n; const float v = logf((float)n / 16.0f) / logf(8.0f) * 16.0f; const int bk = 16 + (int)v; return bk > 31 ? 31 : bk; }

typedef unsigned v4u_dummy_t;
#define XB_TMO      128
#define XB_XCNT(j)  (256  + 64 * (j))
#define XB_XSUB(j)  (1280 + 64 * (j))
#define XB_XGEN(j)  (2304 + 64 * (j))
#define XB_TOP      3328
#define XB_TOPGEN   3392
#define XCD_BAR_WORDS 3456
#define XB_SPIN_CAP (1u << 18)

__device__ __forceinline__ unsigned xb_ld(unsigned* p)              { return __hip_atomic_load(p, __ATOMIC_RELAXED, __HIP_MEMORY_SCOPE_AGENT); }
__device__ __forceinline__ unsigned xb_add(unsigned* p, unsigned v) { return __hip_atomic_fetch_add(p, v, __ATOMIC_RELAXED, __HIP_MEMORY_SCOPE_AGENT); }
__device__ __forceinline__ unsigned xb_xcc_id() { return (unsigned)__builtin_amdgcn_s_getreg((3 << 11) | 20) & 0xFu; }
#define XB_SPIN(cond, bar) do { unsigned _sp = 0; while (cond) { __builtin_amdgcn_s_sleep(1); \
    if ((++_sp & 255u) == 0u) { if (xb_ld(&(bar)[XB_TMO])) break; if (_sp > XB_SPIN_CAP) { atomicAdd(&(bar)[XB_TMO], 1u); break; } } } } while (0)

struct XcdBarrier {
    unsigned* bar; unsigned x;
    volatile LAS unsigned* st;
};

__device__ __forceinline__ XcdBarrier xcd_barrier_post(unsigned* bar, volatile LAS unsigned* st) {
    XcdBarrier b; b.bar = bar; b.x = xb_xcc_id(); b.st = st;
    if (threadIdx.x == 0) (void)xb_add(&bar[XB_XCNT(b.x)], 1u);
    return b;
}
__device__ __forceinline__ void xcd_barrier_complete(unsigned* bar, unsigned x, unsigned& nloc, unsigned& nx) {
    const unsigned G = gridDim.x * gridDim.y * gridDim.z;
    unsigned sum, cnt, mine, sp = 0u;
    for (;;) {
        sum = 0u; cnt = 0u; mine = 0u;
#pragma unroll
        for (unsigned j = 0; j < 16; ++j) { const unsigned c = xb_ld(&bar[XB_XCNT(j)]); sum += c; cnt += (c > 0u) ? 1u : 0u; mine = (j == x) ? c : mine; }
        if (sum == G) break;
        __builtin_amdgcn_s_sleep(1);
        if ((++sp & 255u) == 0u) { if (xb_ld(&bar[XB_TMO])) break; if (sp > XB_SPIN_CAP) { atomicAdd(&bar[XB_TMO], 1u); break; } }
    }
    nloc = mine > 0u ? mine : 1u; nx = cnt > 0u ? cnt : 1u;
}

__device__ __forceinline__ void xcd_barrier(const XcdBarrier& b) {
    asm volatile("s_waitcnt vmcnt(0)" ::: "memory");
    __syncthreads();
    if (threadIdx.x == 0) {
        unsigned* bar = b.bar; asm volatile("" : "+s"(bar));
        __builtin_amdgcn_s_waitcnt(0);
        unsigned nloc = b.st[0], nx = b.st[1];
        if (nloc == 0u) { xcd_barrier_complete(bar, b.x, nloc, nx); b.st[0] = nloc; b.st[1] = nx; }
        const unsigned old = xb_add(&bar[XB_XSUB(b.x)], 1u);
        const unsigned gen = old / nloc;
        if (old + 1u == (gen + 1u) * nloc) {
            __builtin_amdgcn_fence(__ATOMIC_RELEASE, "agent");
            asm volatile("s_waitcnt vmcnt(0)" ::: "memory");
            const unsigned og = xb_add(&bar[XB_TOP], 1u);
            const unsigned tg = og / nx;
            if (og + 1u == (tg + 1u) * nx) xb_add(&bar[XB_TOPGEN], 1u);
            else XB_SPIN(xb_ld(&bar[XB_TOPGEN]) == tg, bar);
            __builtin_amdgcn_fence(__ATOMIC_ACQUIRE, "agent");
            xb_add(&bar[XB_XGEN(b.x)], 1u);
            asm volatile("s_waitcnt vmcnt(0)" ::: "memory");
        } else {
            XB_SPIN(xb_ld(&bar[XB_XGEN(b.x)]) == gen, bar);
            __builtin_amdgcn_fence(__ATOMIC_ACQUIRE, "agent");
            asm volatile("s_waitcnt vmcnt(0)" ::: "memory");
        }
    }
    __syncthreads();
}

struct Args { const float* in[21]; float* out; unsigned char* ws; int ph_lo, ph_hi; };
enum { I_X = 0, I_F1N, I_F1WI, I_F1WO, I_MN, I_WIN, I_QND, I_KND, I_QNS, I_KNS, I_LAM, I_SUBLN, I_SINK, I_RELB, I_WPSB, I_WPD, I_WPSW, I_WOUT, I_F2N, I_F2WI, I_F2WO };
constexpr int N_PHASES = 19;

__global__ void __launch_bounds__(512, 2) mega_fwd(Args a) {
    extern __shared__ __attribute__((aligned(16))) unsigned char lds_raw[];
    LAS unsigned char* lds = (LAS unsigned char*)lds_raw;
    const int tid = threadIdx.x;
    LAS unsigned long long* ptab = (LAS unsigned long long*)(lds + LDS_PTAB);
    if (tid == 0) {
#pragma unroll
        for (int i = 0; i < 21; ++i) ptab[i] = (unsigned long long)(uintptr_t)a.in[i];
    }
    volatile LAS unsigned* barst = (volatile LAS unsigned*)(lds + LDS_BARST);
    if (tid == 0) { barst[0] = 0u; barst[1] = 0u; }
    __syncthreads();
    XcdBarrier xbar = xcd_barrier_post((unsigned*)(a.ws + WS_CTL), barst);
#define INP(i) ((const float*)(uintptr_t)rfl64(ptab[i]))
    for (int ph = a.ph_lo; ph < a.ph_hi; ++ph) {
        unsigned char* ws = a.ws; asm volatile("" : "+s"(ws));
        float* part = (float*)(ws + WS_PART);
        bf16_t* X1 = (bf16_t*)(ws + WS_X1); unsigned char* R = ws + WS_R; bf16_t* HID = (bf16_t*)(R + R_HID); bf16_t* XM = (bf16_t*)a.out;
        if (ph == 0) {
            int tid0 = threadIdx.x; asm volatile("" : "+v"(tid0)); const int lane = tid0 & 63, wave = __builtin_amdgcn_readfirstlane(tid0 >> 6);
            LAS float* scr = (LAS float*)(lds + wave * 16384);
            const int gw = blockIdx.x * 8 + wave, NGW = gridDim.x * 8;
            constexpr int IT_LAYER = 13184, IT_TOTAL = 2 * IT_LAYER;
#define TDECODE(g_, W, gain, WT, K, N, item) do { const int l_ = (g_) >= IT_LAYER ? 1 : 0; const int r_ = (g_) - l_ * IT_LAYER; unsigned char* wl_ = ws + WS_W + (size_t)l_ * W_LAYER; gain = nullptr; \
                if (r_ < 2816) { W = INP(I_F1WI) + (size_t)l_ * D_ * 2 * FF_; gain = INP(I_F1N) + l_ * D_; WT = (bf16_t*)(wl_ + W_1A); K = D_; N = 2 * FF_; item = r_; } \
                else if (r_ < 4224) { W = INP(I_F1WO) + (size_t)l_ * FF_ * D_; WT = (bf16_t*)(wl_ + W_2A); K = FF_; N = D_; item = r_ - 2816; } \
                else if (r_ < 7680) { W = INP(I_WIN) + (size_t)l_ * D_ * 6912; gain = INP(I_MN) + l_ * D_; WT = (bf16_t*)(wl_ + W_IN); K = D_; N = 6912; item = r_ - 4224; } \
                else if (r_ < 7936) { W = INP(I_WPSB) + (size_t)l_ * 512 * D_; WT = (bf16_t*)(wl_ + W_P); K = 512; N = D_; item = r_ - 7680; } \
                else if (r_ < 8192) { W = INP(I_WPD) + (size_t)l_ * 512 * D_; WT = (bf16_t*)(wl_ + W_P) + 512 * D_; K = 512; N = D_; item = r_ - 7936; } \
                else if (r_ < 8448) { W = INP(I_WPSW) + (size_t)l_ * 512 * D_; WT = (bf16_t*)(wl_ + W_P) + 2 * 512 * D_; K = 512; N = D_; item = r_ - 8192; } \
                else if (r_ < 8960) { W = INP(I_WOUT) + (size_t)l_ * D_ * D_; WT = (bf16_t*)(wl_ + W_O); K = D_; N = D_; item = r_ - 8448; } \
                else if (r_ < 11776) { W = INP(I_F2WI) + (size_t)l_ * D_ * 2 * FF_; gain = INP(I_F2N) + l_ * D_; WT = (bf16_t*)(wl_ + W_1B); K = D_; N = 2 * FF_; item = r_ - 8960; } \
                else { W = INP(I_F2WO) + (size_t)l_ * FF_ * D_; WT = (bf16_t*)(wl_ + W_2B); K = FF_; N = D_; item = r_ - 11776; } } while (0)
            if (gw < IT_TOTAL) {
                f32x4 tva[8], tvb[8]; float tga[8], tgb[8];
                const float *Wa, *ga, *Wb, *gb; bf16_t *WTa, *WTb; int Ka, Na, ia, Kb, Nb, ib;
                int g = gw;
                TDECODE(g, Wa, ga, WTa, Ka, Na, ia);
                titem_load(Wa, ga, Na, ia, lane, tva, tga);
                for (;;) {
                    int nx = g + NGW; { const int gq = nx < IT_TOTAL ? nx : IT_TOTAL - 1; TDECODE(gq, Wb, gb, WTb, Kb, Nb, ib); }
                    titem_load(Wb, gb, Nb, ib, lane, tvb, tgb);
                    titem_store(Ka, Na, WTa, scr, ia, lane, tva, tga); g = nx;
                    if (g >= IT_TOTAL) break;
                    nx = g + NGW; { const int gq = nx < IT_TOTAL ? nx : IT_TOTAL - 1; TDECODE(gq, Wa, ga, WTa, Ka, Na, ia); }
                    titem_load(Wa, ga, Na, ia, lane, tva, tga);
                    titem_store(Kb, Nb, WTb, scr, ib, lane, tvb, tgb); g = nx;
                    if (g >= IT_TOTAL) break;
                }
            }
#undef TDECODE
            const float* x = INP(I_X);
            for (int m0 = gw; m0 < M_; m0 += 2 * NGW) {
                f32x4 v[2][4];
#pragma unroll
                for (int u = 0; u < 2; ++u) { const int m = m0 + u * NGW; if (m < M_) { const f32x4* xr = (const f32x4*)(x + (size_t)m * D_) + lane;
#pragma unroll
                    for (int j = 0; j < 4; ++j) v[u][j] = xr[64 * j]; } }
#pragma unroll
                for (int u = 0; u < 2; ++u) { const int m = m0 + u * NGW; if (m < M_) { float s = 0.f;
#pragma unroll
                    for (int j = 0; j < 4; ++j) s += (v[u][j][0] * v[u][j][0] + v[u][j][1] * v[u][j][1]) + (v[u][j][2] * v[u][j][2] + v[u][j][3] * v[u][j][3]);
                    s = wave_sum(s);
                    unsigned long long* o8 = (unsigned long long*)(X1 + (size_t)m * D_) + lane;
#pragma unroll
                    for (int j = 0; j < 4; ++j) o8[64 * j] = (unsigned long long)cvtpk(v[u][j][0], v[u][j][1]) | ((unsigned long long)cvtpk(v[u][j][2], v[u][j][3]) << 32);
                    if (lane < 16) part[(size_t)m * 16 + lane] = lane == 0 ? s : 0.f; } }
            }
        } else {
            const int l = (ph - 1) / 9, k = (ph - 1) % 9; unsigned char* wl = ws + WS_W + (size_t)l * W_LAYER;
            const float lam_init = l == 0 ? 0.2f : (0.8f - 0.6f * 0.7408182206817179f);
            if (k == 0 || k == 7) {
                pg8::Gemm g{}; g.A0 = X1; g.B0 = (const bf16_t*)(wl + (k == 0 ? W_1A : W_1B)); g.K = D_; g.nM = 128; g.nN = 22; g.nbr = 1; g.b_tile_rows = 128; g.b_half_rows = FF_; g.b_spread = 0;
                pg8::EpiSwiglu E{HID, part};
                pg8::gemm_phase(lds, g, E);
            } else if (k == 1 || k == 8 || k == 6) {
                pg8::Gemm g{}; g.nM = 128; g.nN = 4; g.nbr = 1; g.b_tile_rows = 256; g.b_half_rows = 32; g.b_spread = 1;
                pg8::EpiRes E{};
                E.xb = X1; E.outf = nullptr; E.part = part; E.alpha = 0.5f;
                if (k == 1) { g.A0 = HID; g.B0 = (const bf16_t*)(wl + W_2A); g.K = FF_; }
                else if (k == 6) { g.A0 = XM; g.B0 = (const bf16_t*)(wl + W_O); g.K = D_; E.alpha = 1.0f; }
                else { g.A0 = HID; g.B0 = (const bf16_t*)(wl + W_2B); g.K = FF_; if (l == 1) E.outf = a.out; }
                pg8::gemm_phase(lds, g, E);
            } else if (k == 2) {
                pg8::Gemm g{}; g.A0 = X1; g.B0 = (const bf16_t*)(wl + W_IN); g.K = D_; g.nM = 128; g.nN = 15; g.nbr = 1; g.b_tile_rows = 256; g.b_half_rows = 32; g.b_spread = 1;
                pg8::EpiQKV E{part, R, INP(I_QND) + l * 64, INP(I_KND) + l * 64, INP(I_QNS) + l * 64, INP(I_KNS) + l * 64};
                pg8::gemm_phase(lds, g, E);
            } else if (k == 3) {
                LAS float* lut = (LAS float*)(lds + LDS_LUT); LAS float* misc = lut + 12 * 132;
                const float* relb = INP(I_RELB);
                int tid3 = threadIdx.x; asm volatile("" : "+v"(tid3));
                const int ln3 = tid3 & 63;
                float gqd = fabsf(INP(I_QND)[l * 64 + ln3]), gkd = fabsf(INP(I_KND)[l * 64 + ln3]), gqs = fabsf(INP(I_QNS)[l * 64 + ln3]), gks = fabsf(INP(I_KNS)[l * 64 + ln3]);
                const float* lv = INP(I_LAM) + l * 256;
                float d01 = lv[ln3] * lv[64 + ln3], d23 = lv[128 + ln3] * lv[192 + ln3];
#pragma unroll
                for (int o = 1; o < 64; o <<= 1) { gqd = fmaxf(gqd, __shfl_xor(gqd, o)); gkd = fmaxf(gkd, __shfl_xor(gkd, o)); gqs = fmaxf(gqs, __shfl_xor(gqs, o)); gks = fmaxf(gks, __shfl_xor(gks, o));
                    d01 += __shfl_xor(d01, o); d23 += __shfl_xor(d23, o); }
                const float lam = expf(d01) - expf(d23) + lam_init;
                if (tid3 < 12 * 32) {
                    const int head = tid3 >> 5; float mb = fabsf(relb[(tid3 & 31) * 12 + head]);
#pragma unroll
                    for (int o = 1; o < 32; o <<= 1) mb = fmaxf(mb, __shfl_xor(mb, o));
                    if ((tid3 & 31) == 0) misc[head] = (head < 4 ? 8.0f * gqd * gkd : 8.0f * gqs * gks) * 1.02f + mb; }
                __syncthreads();
                for (int e = tid3; e < 12 * 129; e += 512) { const int head = e / 129, d = e % 129;
                    lut[head * 132 + d] = (relb[t5_bucket_dev(d) * 12 + head] - misc[head]) * LOG2E_; }
                __syncthreads();
                for (int v0 = blockIdx.x; v0 < 256; v0 += gridDim.x) {
                    const int v = (v0 & 7) * 32 + (v0 >> 3);
                    { const int bh = v >> 1, b = bh >> 3, h = bh & 7;
                      bf16x8 qr[4]; { int t_ = threadIdx.x; asm volatile("" : "+v"(t_)); sb_prime((LAS char*)lds, t_, b, h, (v & 1) ? 1 : 0, (const bf16_t*)(R + R_QA), R + R_KA, R + R_VA, qr); }
                      for (int i = 0; i < 4; ++i) { const int od = v & 1; const int qb = od ? (i == 0 ? 1 : i == 1 ? 6 : i == 2 ? 3 : 4) : (i == 0 ? 0 : i == 1 ? 7 : i == 2 ? 2 : 5);
                          const int qn = i == 3 ? -1 : (od ? (i == 0 ? 6 : i == 1 ? 3 : 4) : (i == 0 ? 7 : i == 1 ? 2 : 5));
                          sb_unit((LAS char*)lds, b, h, qb, qn, qr, (bf16_t*)(R + R_QA), R + R_KA, R + R_VA); } }
                    { const int bh = v >> 2, b = bh >> 2, h = bh & 3, s = v & 3;
                      bf16x8 qr[4]; { int t_ = threadIdx.x; asm volatile("" : "+v"(t_)); diff_prime((LAS char*)lds, t_, b, h, s, (const bf16_t*)(R + R_QD), R + R_KD, R + R_VD, qr); }
                      for (int i = 0; i < 4; ++i) { const int qb = i == 0 ? s : i == 1 ? 7 - s : i == 2 ? 8 + s : 15 - s;
                          const int qn = i == 0 ? 7 - s : i == 1 ? 8 + s : i == 2 ? 15 - s : -1;
                          diff_unit((LAS char*)lds, lut + h * 132, b, h, qb, qn, qr, (bf16_t*)(R + R_QD), R + R_KD, R + R_VD, lam, INP(I_SUBLN) + l * 128, 1.0f - lam_init); } }
                    { bf16x8 qr[4]; const int un0 = v * 4, b = un0 >> 6, hq = (un0 >> 3) & 7;
                      const float sink_term = fexp2((INP(I_SINK)[l * 8 + hq] - misc[4 + hq]) * LOG2E_);
                      { int t_ = threadIdx.x; asm volatile("" : "+v"(t_)); swa_prime((LAS char*)lds, t_, b, hq, un0 & 7, (const bf16_t*)(R + R_QS), R + R_KS, R + R_VS, qr); }
                      for (int i = 0; i < 4; ++i) { const int qb = (un0 & 7) + i;
                        swa_unit((LAS char*)lds, lut + (4 + hq) * 132, b, hq, qb, i == 3 ? -1 : qb + 1, qr, (bf16_t*)(R + R_QS), R + R_KS, R + R_VS, sink_term); } }
                }
            } else if (k == 4) {
                pg8::Gemm g{}; g.A0 = X1; g.B0 = (const bf16_t*)(wl + W_IN) + (size_t)3840 * D_; g.K = D_; g.nM = 128; g.nN = 12; g.nbr = 1; g.b_tile_rows = 256; g.b_half_rows = 32; g.b_spread = 1;
                pg8::EpiGate E{part, (bf16_t*)(R + R_G)};
                pg8::gemm_phase(lds, g, E);
            } else {
                pg8::Gemm g{}; g.K = 512; g.nM = 128; g.nN = 4; g.nbr = 3; g.b_tile_rows = 256; g.b_half_rows = 32; g.b_spread = 1;
                g.A0 = (const bf16_t*)(R + R_QA); g.sA = 32 * MiB;
                g.B0 = (const bf16_t*)(wl + W_P); g.sB = (size_t)512 * D_ * 2;
                pg8::EpiMerge E{(const bf16_t*)(R + R_G), XM};
                pg8::gemm_phase(lds, g, E);
            }
        }
        if (ph + 1 < a.ph_hi) { if (a.ph_hi > 1000) cg::this_grid().sync(); else xcd_barrier(xbar); }
    }
}

extern "C" void kernel_launch(void* const* d_in, const int* in_sizes, int n_in, void* d_out, int out_size, void* d_ws, size_t ws_size, hipStream_t stream) {
    static int grid = 0;
    if (grid == 0) {
        if (n_in != 21 || in_sizes[0] != M_ * D_ || out_size != M_ * D_ || ws_size < WS_END) { fprintf(stderr, "kernel_launch: unexpected shapes / workspace (%d inputs, ws %zu)\n", n_in, ws_size); grid = -1; return; }
        int dev = 0, cus = 0, per_cu = 0;
        hipGetDevice(&dev); hipDeviceGetAttribute(&cus, hipDeviceAttributeMultiprocessorCount, dev);
        hipFuncSetAttribute((const void*)mega_fwd, hipFuncAttributeMaxDynamicSharedMemorySize, LDS_BYTES);
        if (hipOccupancyMaxActiveBlocksPerMultiprocessor(&per_cu, (const void*)mega_fwd, 512, LDS_BYTES) != hipSuccess || per_cu < 1) per_cu = 1;
        (void)hipGetLastError();
        grid = cus * 1;
        if (grid <= 0) grid = 256;
    }
    if (grid < 0) return;
    if (hipMemsetAsync((char*)d_ws + WS_CTL, 0, CTL_BYTES, stream) != hipSuccess) { fprintf(stderr, "kernel_launch: memset failed\n"); return; }
    Args a{};
    for (int i = 0; i < 21; ++i) a.in[i] = (const float*)d_in[i];
    a.out = (float*)d_out; a.ws = (unsigned char*)d_ws;
#if MK_PER_PHASE_LAUNCH
    for (int ph = 0; ph < N_PHASES; ++ph) { a.ph_lo = ph; a.ph_hi = ph + 1; hipLaunchKernelGGL(mega_fwd, dim3(grid), dim3(512), LDS_BYTES, stream, a); }
#else
    a.ph_lo = 0; a.ph_hi = N_PHASES;
    void* args[] = {&a};
    hipError_t e = hipLaunchCooperativeKernel((const void*)mega_fwd, dim3(grid), dim3(512), args, LDS_BYTES, stream);
    if (e != hipSuccess) fprintf(stderr, "cooperative launch failed: %s (grid %d)\n", hipGetErrorString(e), grid);
#endif
}
```
